# Optimizing an MI355X kernel written in HIP

```python
import jax, jax.numpy as jnp
from jax import lax
import numpy as np


D_MODEL = 1024
BATCH = 8
SEQ = 8192
DEPTH = 1

N_Q_HEADS = 16
N_KV_HEADS = 4
HEAD_DIM = 64
WINDOW = 128
ATTN_BLOCK = 128
ROPE_THETA = 500000.0
ROPE_DIM = HEAD_DIM // 4
HGRN_HEADS = 8
HGRN_DK = 128
HGRN_DV = 128
HGRN_CHUNK = 64
D_FF = 2816
ATTN_WIDTH = N_Q_HEADS * HEAD_DIM
KV_WIDTH = N_KV_HEADS * HEAD_DIM
HGRN_KWIDTH = HGRN_HEADS * HGRN_DK
HGRN_VWIDTH = HGRN_HEADS * HGRN_DV
IN_WIDTHS = (ATTN_WIDTH, KV_WIDTH, KV_WIDTH, HGRN_KWIDTH, HGRN_KWIDTH, HGRN_VWIDTH, HGRN_VWIDTH, D_MODEL, D_MODEL)
D_IN = sum(IN_WIDTHS)
DEEPNORM_ALPHA = (2 * DEPTH) ** 0.25
DEEPNORM_BETA = (8 * DEPTH) ** -0.25
LN_EPS = 1e-5
RMS_EPS = 1e-6
NEG_INF = -1e30

kernel_name = 'hybrid_swa_sink_hgrn2_macaron_deepnorm'


def layer_norm(x, g, b):
    xf = x.astype(jnp.float32)
    mu = jnp.mean(xf, axis=-1, keepdims=True)
    var = jnp.mean(jnp.square(xf - mu), axis=-1, keepdims=True)
    y = (xf - mu) * lax.rsqrt(var + LN_EPS) * g.astype(jnp.float32) + b.astype(jnp.float32)
    return y.astype(x.dtype)


def swiglu(x, w1, w3, w2):
    return (jax.nn.silu(x @ w1) * (x @ w3)) @ w2


def rope_tables(seq_len):
    pos = jnp.arange(seq_len, dtype=jnp.float32)
    inv_freq = ROPE_THETA ** (-jnp.arange(0, ROPE_DIM, 2, dtype=jnp.float32) / ROPE_DIM)
    ang = pos[:, None] * inv_freq[None, :]
    return jnp.cos(ang)[None, :, None, :], jnp.sin(ang)[None, :, None, :]


def partial_rope(t, cos, sin):
    tf = t.astype(jnp.float32)
    half = ROPE_DIM // 2
    t1, t2, rest = tf[..., :half], tf[..., half:ROPE_DIM], tf[..., ROPE_DIM:]
    rot = jnp.concatenate([t1 * cos - t2 * sin, t2 * cos + t1 * sin, rest], axis=-1)
    return rot.astype(t.dtype)


def sliding_window_attention(q, k, v, sinks):
    B, S = q.shape[0], q.shape[1]
    nb = S // ATTN_BLOCK
    grp = N_Q_HEADS // N_KV_HEADS
    qb = q.reshape(B, nb, ATTN_BLOCK, N_KV_HEADS, grp, HEAD_DIM)

    def band(t):
        tp = jnp.pad(t, ((0, 0), (ATTN_BLOCK, 0), (0, 0), (0, 0)))
        tp = tp.reshape(B, nb + 1, ATTN_BLOCK, N_KV_HEADS, HEAD_DIM)
        return jnp.concatenate([tp[:, :-1], tp[:, 1:]], axis=2)

    kb, vb = band(k), band(v)
    scores = jnp.einsum('bnqkgd,bnskd->bnkgqs', qb, kb).astype(jnp.float32) * (HEAD_DIM ** -0.5)
    qi = jnp.arange(ATTN_BLOCK)[:, None]
    kj = jnp.arange(2 * ATTN_BLOCK)[None, :]
    blk = jnp.arange(nb)[:, None, None]
    dist = qi + ATTN_BLOCK - kj
    mask = (dist >= 0) & (dist < WINDOW) & (blk * ATTN_BLOCK + kj - ATTN_BLOCK >= 0)
    scores = jnp.where(mask[None, :, None, None], scores, NEG_INF)
    sink = sinks.astype(jnp.float32).reshape(1, 1, N_KV_HEADS, grp, 1, 1)
    m = jnp.maximum(jnp.max(scores, axis=-1, keepdims=True), sink)
    p = jnp.exp(scores - m)
    denom = jnp.sum(p, axis=-1, keepdims=True) + jnp.exp(sink - m)
    probs = (p / denom).astype(v.dtype)
    out = jnp.einsum('bnkgqs,bnskd->bnqkgd', probs, vb)
    return out.reshape(B, S, ATTN_WIDTH)


def hgrn2_recurrence(q, f_logit, v, lb):
    B, S = q.shape[0], q.shape[1]
    nc = S // HGRN_CHUNK
    lb = lb.reshape(HGRN_HEADS, HGRN_DK)
    f = lb + (1.0 - lb) * jax.nn.sigmoid(f_logit.astype(jnp.float32))
    k = 1.0 - f

    def chunks(t):
        return t.reshape(B, nc, HGRN_CHUNK, HGRN_HEADS, t.shape[-1]).transpose(0, 3, 1, 2, 4)

    qc, kc, vc = chunks(q.astype(jnp.float32)), chunks(k), chunks(v.astype(jnp.float32))
    gc = jnp.cumsum(chunks(jnp.log(f)), axis=3)
    g_last = gc[:, :, :, -1:, :]
    q_dec = qc * jnp.exp(gc)
    k_inv = kc * jnp.exp(-gc)
    k_end = kc * jnp.exp(g_last - gc)
    causal = jnp.tril(jnp.ones((HGRN_CHUNK, HGRN_CHUNK), dtype=bool))
    scores = jnp.where(causal, jnp.einsum('bhntd,bhnsd->bhnts', q_dec, k_inv), 0.0)
    o_intra = jnp.einsum('bhnts,bhnse->bhnte', scores, vc)
    upd = jnp.einsum('bhnsd,bhnse->bhnde', k_end, vc)
    decay = jnp.exp(g_last[:, :, :, 0, :])

    def step(state, inp):
        a_n, u_n = inp
        return state * a_n[..., None] + u_n, state

    s0 = jnp.zeros((B, HGRN_HEADS, HGRN_DK, HGRN_DV), jnp.float32)
    _, s_start = lax.scan(step, s0, (jnp.moveaxis(decay, 2, 0), jnp.moveaxis(upd, 2, 0)))
    s_start = jnp.moveaxis(s_start, 0, 2)
    o = o_intra + jnp.einsum('bhntd,bhnde->bhnte', q_dec, s_start)
    return o.transpose(0, 2, 3, 1, 4).reshape(B, S, HGRN_HEADS, HGRN_DV)


def token_mixer(h, w_in, b_in, sinks, lb, norm_g, w_pa, w_ph, w_out, cos, sin):
    B, S = h.shape[0], h.shape[1]
    proj = h @ w_in + b_in
    splits = np.cumsum(IN_WIDTHS)[:-1].tolist()
    q_a, k_a, v_a, f_h, q_h, i_h, og_h, gate_a, gate_h = jnp.split(proj, splits, axis=-1)
    q_a = partial_rope(q_a.reshape(B, S, N_Q_HEADS, HEAD_DIM), cos, sin)
    k_a = partial_rope(k_a.reshape(B, S, N_KV_HEADS, HEAD_DIM), cos, sin)
    v_a = v_a.reshape(B, S, N_KV_HEADS, HEAD_DIM)
    y_attn = sliding_window_attention(q_a, k_a, v_a, sinks)
    q_h = jax.nn.silu(q_h).reshape(B, S, HGRN_HEADS, HGRN_DK)
    o_h = hgrn2_recurrence(q_h, f_h.reshape(B, S, HGRN_HEADS, HGRN_DK),
                           i_h.reshape(B, S, HGRN_HEADS, HGRN_DV), lb)
    o_h = o_h * lax.rsqrt(jnp.mean(jnp.square(o_h), axis=-1, keepdims=True) + RMS_EPS) * norm_g.astype(jnp.float32)
    y_hgrn = o_h.reshape(B, S, HGRN_VWIDTH).astype(h.dtype) * jax.nn.silu(og_h)
    merged = jax.nn.sigmoid(gate_a) * (y_attn @ w_pa) + jax.nn.sigmoid(gate_h) * (y_hgrn @ w_ph)
    return merged @ w_out


def setup_inputs(seed: int = 0) -> dict:
    key = jax.random.key(seed)
    ks = jax.random.split(key, 24)

    def nrm(k, shape, scale):
        return jax.random.normal(k, shape, jnp.float32) * scale

    D = D_MODEL
    return {
        'x': nrm(ks[0], (BATCH, SEQ, D), 1.0),
        'ln1_g': 1.0 + nrm(ks[1], (DEPTH, D), 0.02),
        'ln1_b': nrm(ks[2], (DEPTH, D), 0.02),
        'ffn1_w1': nrm(ks[3], (DEPTH, D, D_FF), D ** -0.5),
        'ffn1_w3': nrm(ks[4], (DEPTH, D, D_FF), D ** -0.5),
        'ffn1_w2': nrm(ks[5], (DEPTH, D_FF, D), D_FF ** -0.5 * DEEPNORM_BETA),
        'ln2_g': 1.0 + nrm(ks[6], (DEPTH, D), 0.02),
        'ln2_b': nrm(ks[7], (DEPTH, D), 0.02),
        'w_in': nrm(ks[8], (DEPTH, D, D_IN), D ** -0.5),
        'b_in': nrm(ks[9], (DEPTH, D_IN), 0.02),
        'attn_sinks': nrm(ks[10], (DEPTH, N_Q_HEADS), 0.5),
        'hgrn_lb_logits': nrm(ks[11], (DEPTH + 1, HGRN_KWIDTH), 0.1),
        'hgrn_norm_g': 1.0 + nrm(ks[12], (DEPTH, HGRN_DV), 0.02),
        'w_proj_attn': nrm(ks[13], (DEPTH, ATTN_WIDTH, D), ATTN_WIDTH ** -0.5 * DEEPNORM_BETA),
        'w_proj_hgrn': nrm(ks[14], (DEPTH, HGRN_VWIDTH, D), HGRN_VWIDTH ** -0.5 * DEEPNORM_BETA),
        'w_out': nrm(ks[15], (DEPTH, D, D), D ** -0.5 * DEEPNORM_BETA),
        'ln3_g': 1.0 + nrm(ks[16], (DEPTH, D), 0.02),
        'ln3_b': nrm(ks[17], (DEPTH, D), 0.02),
        'ffn2_w1': nrm(ks[18], (DEPTH, D, D_FF), D ** -0.5),
        'ffn2_w3': nrm(ks[19], (DEPTH, D, D_FF), D ** -0.5),
        'ffn2_w2': nrm(ks[20], (DEPTH, D_FF, D), D_FF ** -0.5 * DEEPNORM_BETA),
    }


def reference(x, ln1_g, ln1_b, ffn1_w1, ffn1_w3, ffn1_w2, ln2_g, ln2_b, w_in, b_in,
              attn_sinks, hgrn_lb_logits, hgrn_norm_g, w_proj_attn, w_proj_hgrn, w_out,
              ln3_g, ln3_b, ffn2_w1, ffn2_w3, ffn2_w2):
    cos, sin = rope_tables(x.shape[1])
    lb_all = jnp.cumsum(jax.nn.softmax(hgrn_lb_logits.astype(jnp.float32), axis=0), axis=0)
    for l in range(DEPTH):
        x = layer_norm(DEEPNORM_ALPHA * x + 0.5 * swiglu(x, ffn1_w1[l], ffn1_w3[l], ffn1_w2[l]),
                       ln1_g[l], ln1_b[l])
        mix = token_mixer(x, w_in[l], b_in[l], attn_sinks[l], lb_all[l], hgrn_norm_g[l],
                          w_proj_attn[l], w_proj_hgrn[l], w_out[l], cos, sin)
        x = layer_norm(DEEPNORM_ALPHA * x + mix, ln2_g[l], ln2_b[l])
        x = layer_norm(DEEPNORM_ALPHA * x + 0.5 * swiglu(x, ffn2_w1[l], ffn2_w3[l], ffn2_w2[l]),
                       ln3_g[l], ln3_b[l])
    return x
```

```cpp
#include <hip/hip_runtime.h>
#include <hip/hip_cooperative_groups.h>
#include <cstdio>
#include <cstdint>
#include <cmath>
namespace cg = cooperative_groups;

#ifndef MK_PER_PHASE
#define MK_PER_PHASE 0
#endif

#define LAS __attribute__((address_space(3)))
typedef unsigned short bf16_t;
typedef short bf16x8 __attribute__((ext_vector_type(8)));
typedef float f32x4 __attribute__((ext_vector_type(4)));
typedef unsigned u32x4 __attribute__((ext_vector_type(4)));
typedef unsigned u32x2 __attribute__((ext_vector_type(2)));

constexpr int D = 1024, BATCH = 8, SEQ = 8192, M = BATCH * SEQ, DFF = 2816, NPJ = 5632, NIN = 7680;
constexpr float ALPHA = 1.189207115002721f;
constexpr float LN_EPS = 1e-5f, RMS_EPS = 1e-6f;
constexpr int PC_Q = 0, PC_I = 1024, PC_F = 2048, PC_QH = 3072, PC_K = 4096, PC_V = 4352, PC_OG = 4608;

constexpr size_t MiB = 1u << 20;
constexpr size_t WS_TAB = 1 * MiB;
constexpr size_t WS_ROPE = WS_TAB, WS_LB = WS_TAB + 512 * 1024, WS_BIAS = WS_LB + 4096;
constexpr size_t WS_W13A = 2 * MiB, WS_W2A = 13 * MiB, WS_WIN = 19 * MiB, WS_WM = 34 * MiB, WS_WOUT = 38 * MiB, WS_W13B = 40 * MiB, WS_W2B = 51 * MiB;
constexpr size_t WS_XB = 64 * MiB;
constexpr size_t WS_PJ = 192 * MiB;
constexpr size_t WS_END = 896 * MiB;

__device__ __forceinline__ unsigned cvt_pk_bf16(float lo, float hi) { unsigned r; asm volatile("v_cvt_pk_bf16_f32 %0, %1, %2" : "=v"(r) : "v"(lo), "v"(hi)); return r; }
__device__ __forceinline__ float bf2f(unsigned short v) { return __uint_as_float((unsigned)v << 16); }
__device__ __forceinline__ float bflo(unsigned v) { return __uint_as_float(v << 16); }
__device__ __forceinline__ float bfhi(unsigned v) { return __uint_as_float(v & 0xffff0000u); }
__device__ __forceinline__ float sigmoidf_(float x) { return __builtin_amdgcn_rcpf(1.0f + __expf(-x)); }
__device__ __forceinline__ float siluf_(float x) { return x * sigmoidf_(x); }

namespace pg8 {
constexpr int BM = 256, BK = 64, HALF = 128, HTB = HALF * BK * 2, STAGE_BYTES = 8 * HTB, NXCD = 8, WGM = 8;
__host__ __device__ __forceinline__ int lds_byte(int r, int c) { const int st = (r >> 4) * 2 + (c >> 5), rr = r & 15, cc = c & 31, ob = rr * 64 + cc * 2; return st * 1024 + (ob ^ (((ob >> 9) & 1) << 5)); }
__host__ __device__ __forceinline__ void stage_rc(int b, int& R, int& C) { const int st = b / 1024, sb = b % 1024, swz = sb ^ (((sb >> 9) & 1) << 5); R = (st >> 1) * 16 + swz / 64; C = (st & 1) * 32 + (swz % 64) / 2; }
__host__ __device__ __forceinline__ int perm32(int rho) { const int n = rho >> 4, i = rho & 15; return 8 * (i >> 2) + 4 * n + (i & 3); }

struct Unit { int pm, pn; };
struct Gemm { const bf16_t* A; const bf16_t* Bt; int lda, ldb, K, M, N; int subA, subB; };

struct StaticOrder {
    int nM, nN, nwg, G, c;
    __host__ __device__ void init(int M_, int N_, int G_, int c_) { nM = M_ / BM; nN = N_ / BM; nwg = nM * nN; G = G_; c = c_; }
    __host__ __device__ bool next(int i, Unit& u) const {
        const long L = (long)i * G + c; if (L >= nwg) return false;
        int wgid = (int)L; { const int q = nwg / NXCD, r = nwg % NXCD, xcd = wgid % NXCD, off = wgid / NXCD; wgid = (xcd < r ? xcd * (q + 1) : r * (q + 1) + (xcd - r) * q) + off; }
        const int nig = WGM * nN, gid = wgid / nig, fm = gid * WGM, gsz = (nM - fm) < WGM ? (nM - fm) : WGM;
        u.pm = fm + ((wgid % nig) % gsz); u.pn = (wgid % nig) / gsz; return true;
    }
};

typedef f32x4 Acc[2][2][4][2];

template <class Epi>
__device__ __forceinline__ void gemm_phase(LAS unsigned char* lds, const Gemm g, const StaticOrder& S, const Epi& E) {
    const int tid = threadIdx.x, wid = __builtin_amdgcn_readfirstlane(tid >> 6), lane = tid & 63, wr = wid >> 2, wc = wid & 3, fr = lane & 15, fq = lane >> 4;
    const int K = g.K, nt = K / BK;
    unsigned voffA[2], voffB[2];
#pragma unroll
    for (int i = 0; i < 2; ++i) { int R, C; stage_rc(tid * 16 + i * 8192, R, C); const int Rb = (R & ~31) + perm32(R & 31);
        voffA[i] = (unsigned)(R * g.lda + C) * 2u; voffB[i] = (unsigned)(Rb * g.ldb + C) * 2u; }
    const size_t kstep = (size_t)(BK * 2);
    const size_t hstepA = (size_t)HALF * g.lda * 2, hstepB = (size_t)HALF * g.ldb * 2;
    const size_t tstepA = 2 * hstepA, tstepB = 2 * hstepB;
    const unsigned ldsw = (unsigned)wid * 1024u;
    const int aoff = lds_byte(wr * 64 + fr, fq * 8), boff = lds_byte(wc * 32 + fr, fq * 8);
#define PG8_SA(b, h) (((b) * 2 + (h)) * HTB)
#define PG8_SB(b, h) ((4 + (b) * 2 + (h)) * HTB)
#define PG8_STAGE(bufoff, gbase, voff) do { _Pragma("unroll") for (int _i = 0; _i < 2; ++_i) \
        __builtin_amdgcn_global_load_lds((const unsigned*)((const char*)(gbase) + (voff)[_i]), (LAS unsigned*)(lds + (bufoff) + ldsw + _i * 8192), 16, 0, 0); } while (0)
#define PG8_LDA(dst, b, h) do { _Pragma("unroll") for (int m = 0; m < 4; ++m) _Pragma("unroll") for (int k = 0; k < 2; ++k) dst[m][k] = *(const LAS bf16x8*)(lds + PG8_SA(b, h) + aoff + m * 2048 + k * 1024); } while (0)
#define PG8_LDB(dst, b, h) do { _Pragma("unroll") for (int n = 0; n < 2; ++n) _Pragma("unroll") for (int k = 0; k < 2; ++k) dst[n][k] = *(const LAS bf16x8*)(lds + PG8_SB(b, h) + boff + n * 2048 + k * 1024); } while (0)
#define PG8_MMA(ai, bj, At, Bt) do { __builtin_amdgcn_s_setprio(1); _Pragma("unroll") for (int m = 0; m < 4; ++m) _Pragma("unroll") for (int n = 0; n < 2; ++n) _Pragma("unroll") for (int k = 0; k < 2; ++k) \
        acc[ai][bj][m][n] = __builtin_amdgcn_mfma_f32_16x16x32_bf16(Bt[n][k], At[m][k], acc[ai][bj][m][n], 0, 0, 0); __builtin_amdgcn_s_setprio(0); } while (0)
#define PG8_WAIT_V(n) asm volatile("s_waitcnt vmcnt(" #n ")" ::: "memory")
#define PG8_WAIT_L(n) asm volatile("s_waitcnt lgkmcnt(" #n ")" ::: "memory")
#define PG8_BAR __builtin_amdgcn_s_barrier()
#define PG8_SCHED __builtin_amdgcn_sched_barrier(0)
    constexpr int NSUB = Epi::NSUB;
    Unit cur, nxt; int ui = 0, csub = 0, nsub = 0;
    if (!S.next(0, cur)) return;
    Acc acc;
#pragma unroll
    for (int a = 0; a < 2; ++a)
#pragma unroll
        for (int b = 0; b < 2; ++b)
#pragma unroll
            for (int m = 0; m < 4; ++m)
#pragma unroll
                for (int n = 0; n < 2; ++n) acc[a][b][m][n] = (f32x4){0.f, 0.f, 0.f, 0.f};
    bf16x8 At[4][2], B0[2][2], B1[2][2];
    const char* cA = (const char*)g.A + (size_t)cur.pm * tstepA; const char* cB = (const char*)g.Bt + (size_t)cur.pn * tstepB;
    PG8_STAGE(PG8_SB(0, 0), cB, voffB); PG8_STAGE(PG8_SB(0, 1), cB + hstepB, voffB); PG8_STAGE(PG8_SA(0, 0), cA, voffA); PG8_STAGE(PG8_SA(0, 1), cA + hstepA, voffA);
    if (wr == 1) PG8_BAR;
    PG8_WAIT_V(2); PG8_BAR;
    PG8_STAGE(PG8_SB(1, 0), cB + kstep, voffB); PG8_STAGE(PG8_SA(1, 0), cA + kstep, voffA); PG8_STAGE(PG8_SB(1, 1), cB + hstepB + kstep, voffB);
    PG8_WAIT_V(6); PG8_BAR;
    for (;;) {
        nsub = (ui + 1) % NSUB;
        const bool has_next = S.next((ui + 1) / NSUB, nxt);
        const char* nA = has_next ? (const char*)g.A + (size_t)nxt.pm * tstepA + (size_t)nsub * g.subA : cA; const char* nB = has_next ? (const char*)g.Bt + (size_t)nxt.pn * tstepB + (size_t)nsub * g.subB : cB;
        for (int t = 0; t < nt; t += 2) {
            const bool last = (t == nt - 2);
            const char* a1 = cA + (size_t)(t + 1) * kstep;
            const char* a2 = last ? nA : cA + (size_t)(t + 2) * kstep; const char* b2 = last ? nB : cB + (size_t)(t + 2) * kstep;
            const char* a3 = a2 + kstep; const char* b3 = b2 + kstep;
            PG8_LDB(B0, 0, 0); PG8_LDB(B1, 0, 1); PG8_SCHED; PG8_LDA(At, 0, 0); PG8_STAGE(PG8_SA(1, 1), a1 + hstepA, voffA);
            PG8_WAIT_V(8); PG8_WAIT_L(0); PG8_BAR; PG8_MMA(0, 0, At, B0); PG8_MMA(0, 1, At, B1); PG8_BAR; PG8_SCHED;
            PG8_LDA(At, 0, 1); PG8_STAGE(PG8_SB(0, 0), b2, voffB); PG8_STAGE(PG8_SB(0, 1), b2 + hstepB, voffB); PG8_STAGE(PG8_SA(0, 0), a2, voffA);
            PG8_WAIT_V(8); PG8_WAIT_L(0); PG8_BAR; PG8_MMA(1, 0, At, B0); PG8_MMA(1, 1, At, B1); PG8_BAR; PG8_SCHED;
            PG8_LDB(B0, 1, 0); PG8_LDB(B1, 1, 1); PG8_SCHED; PG8_LDA(At, 1, 0); PG8_STAGE(PG8_SA(0, 1), a2 + hstepA, voffA);
            PG8_WAIT_V(8); PG8_WAIT_L(0); PG8_BAR; PG8_MMA(0, 0, At, B0); PG8_MMA(0, 1, At, B1); PG8_BAR; PG8_SCHED;
            PG8_LDA(At, 1, 1); PG8_STAGE(PG8_SB(1, 0), b3, voffB); PG8_STAGE(PG8_SB(1, 1), b3 + hstepB, voffB); PG8_STAGE(PG8_SA(1, 0), a3, voffA);
            PG8_WAIT_V(8); PG8_WAIT_L(0); PG8_BAR; PG8_MMA(1, 0, At, B0); PG8_MMA(1, 1, At, B1); PG8_BAR; PG8_SCHED;
        }
        if (wr == 0) PG8_BAR;
        E(acc, cur, csub, wr, wc, fr, fq);
        if (!has_next) break;
        if (NSUB == 1 || nsub == 0) {
#pragma unroll
        for (int a = 0; a < 2; ++a)
#pragma unroll
            for (int b = 0; b < 2; ++b)
#pragma unroll
                for (int m = 0; m < 4; ++m)
#pragma unroll
                    for (int n = 0; n < 2; ++n) acc[a][b][m][n] = (f32x4){0.f, 0.f, 0.f, 0.f};
        }
        cur = nxt; csub = nsub; cA = nA; cB = nB; ++ui;
        if (wr == 1) PG8_BAR;
    }
    PG8_WAIT_V(0);
    PG8_BAR;
#undef PG8_SA
#undef PG8_SB
#undef PG8_STAGE
#undef PG8_LDA
#undef PG8_LDB
#undef PG8_MMA
#undef PG8_WAIT_V
#undef PG8_WAIT_L
#undef PG8_BAR
#undef PG8_SCHED
}

__device__ __forceinline__ u32x4 pack8(const f32x4 a, const f32x4 b) { u32x4 w; w.x = cvt_pk_bf16(a[0], a[1]); w.y = cvt_pk_bf16(a[2], a[3]); w.z = cvt_pk_bf16(b[0], b[1]); w.w = cvt_pk_bf16(b[2], b[3]); return w; }

struct EpiSwiglu {
    static constexpr int NSUB = 1;
    bf16_t* H;
    __device__ __forceinline__ void operator()(Acc& acc, const Unit& u, int sub, int wr, int wc, int fr, int fq) const {
        const int row0 = u.pm * BM + wr * 64 + fr, col = u.pn * 128 + wc * 32 + 8 * fq;
#pragma unroll
        for (int ai = 0; ai < 2; ++ai)
#pragma unroll
            for (int m = 0; m < 4; ++m) {
                f32x4 h0, h1;
#pragma unroll
                for (int i = 0; i < 4; ++i) { h0[i] = siluf_(acc[ai][0][m][0][i]) * acc[ai][1][m][0][i]; h1[i] = siluf_(acc[ai][0][m][1][i]) * acc[ai][1][m][1][i]; }
                *(u32x4*)(H + (size_t)(row0 + ai * HALF + m * 16) * DFF + col) = pack8(h0, h1);
            }
    }
};
struct EpiResid {
    static constexpr int NSUB = 1;
    const float* res; float* out; float alpha, s;
    __device__ __forceinline__ void operator()(Acc& acc, const Unit& u, int sub, int wr, int wc, int fr, int fq) const {
        const int row0 = u.pm * BM + wr * 64 + fr, col0 = u.pn * BM + wc * 32 + 8 * fq;
#pragma unroll
        for (int ai = 0; ai < 2; ++ai)
#pragma unroll
            for (int m = 0; m < 4; ++m) {
#pragma unroll
                for (int bj = 0; bj < 2; ++bj) { const size_t off = (size_t)(row0 + ai * HALF + m * 16) * D + col0 + bj * HALF;
                    const f32x4 r0 = *(const f32x4*)(res + off), r1 = *(const f32x4*)(res + off + 4);
                    *(f32x4*)(out + off) = r0 * alpha + acc[ai][bj][m][0] * s; *(f32x4*)(out + off + 4) = r1 * alpha + acc[ai][bj][m][1] * s; }
                asm volatile("" ::: "memory");
            }
    }
};
struct EpiProj {
    static constexpr int NSUB = 1;
    bf16_t* P; const float* bias; const float* lb; const float* rope;
    __device__ __forceinline__ void operator()(Acc& acc, const Unit& u, int sub, int wr, int wc, int fr, int fq) const {
        const int row0 = u.pm * BM + wr * 64 + fr; const int pn = u.pn;
        const int kind = pn < 4 ? 0 : pn < 8 ? 1 : pn < 12 ? 2 : pn < 16 ? 3 : pn == 16 ? 4 : pn == 17 ? 1 : 3;
#pragma unroll
        for (int bj = 0; bj < 2; ++bj) {
            const int c = pn * BM + bj * HALF + wc * 32 + 8 * fq;
            const f32x4 b0 = *(const f32x4*)(bias + c), b1 = *(const f32x4*)(bias + c + 4);
            f32x4 l0 = (f32x4){0.f, 0.f, 0.f, 0.f}, l1 = l0;
            if (kind == 2) { l0 = *(const f32x4*)(lb + (c - PC_F)); l1 = *(const f32x4*)(lb + (c - PC_F) + 4); }
#pragma unroll
            for (int ai = 0; ai < 2; ++ai)
#pragma unroll
                for (int m = 0; m < 4; ++m) {
                    const int row = row0 + ai * HALF + m * 16;
                    f32x4 v0 = acc[ai][bj][m][0] + b0, v1 = acc[ai][bj][m][1] + b1;
                    if (kind == 0 || kind == 4) {
                        f32x4 p0, p1;
#pragma unroll
                        for (int i = 0; i < 4; ++i) { p0[i] = __shfl_xor(v0[i], 16); p1[i] = __shfl_xor(v1[i], 16); }
                        if ((wc & 1) == 0 && fq < 2) {
                            const float* tb = rope + (size_t)(row & (SEQ - 1)) * 16;
                            const f32x4 c0 = *(const f32x4*)(tb), c1 = *(const f32x4*)(tb + 4), s0 = *(const f32x4*)(tb + 8), s1 = *(const f32x4*)(tb + 12);
                            const float sg = fq == 0 ? -1.f : 1.f;
                            v0 = v0 * c0 + p0 * s0 * sg; v1 = v1 * c1 + p1 * s1 * sg;
                        }
                        if (kind == 0) { v0 = v0 * 0.125f; v1 = v1 * 0.125f; }
                    } else if (kind == 2) {
#pragma unroll
                        for (int i = 0; i < 4; ++i) { v0[i] = __logf(l0[i] + (1.f - l0[i]) * sigmoidf_(v0[i])); v1[i] = __logf(l1[i] + (1.f - l1[i]) * sigmoidf_(v1[i])); }
                    } else if (kind == 3) {
#pragma unroll
                        for (int i = 0; i < 4; ++i) { v0[i] = siluf_(v0[i]); v1[i] = siluf_(v1[i]); }
                    }
                    *(u32x4*)(P + (size_t)row * NPJ + c) = pack8(v0, v1);
                }
        }
    }
};
struct EpiGate {
    static constexpr int NSUB = 1;
    bf16_t* P; const float* bias;
    __device__ __forceinline__ void operator()(Acc& acc, const Unit& u, int sub, int wr, int wc, int fr, int fq) const {
        const int row0 = u.pm * BM + wr * 64 + fr;
#pragma unroll
        for (int bj = 0; bj < 2; ++bj) {
            const int c = u.pn * BM + bj * HALF + wc * 32 + 8 * fq;
            const f32x4 b0 = *(const f32x4*)(bias + NPJ + c), b1 = *(const f32x4*)(bias + NPJ + c + 4);
#pragma unroll
            for (int ai = 0; ai < 2; ++ai)
#pragma unroll
                for (int m = 0; m < 4; ++m) {
                    f32x4 v0 = acc[ai][bj][m][0] + b0, v1 = acc[ai][bj][m][1] + b1;
#pragma unroll
                    for (int i = 0; i < 4; ++i) { v0[i] = sigmoidf_(v0[i]); v1[i] = sigmoidf_(v1[i]); }
                    *(u32x4*)(P + (size_t)(row0 + ai * HALF + m * 16) * NPJ + PC_F + c) = pack8(v0, v1);
                }
        }
    }
};
struct EpiMerge {
    static constexpr int NSUB = 2;
    const bf16_t* P; bf16_t* O;
    __device__ __forceinline__ void operator()(Acc& acc, const Unit& u, int sub, int wr, int wc, int fr, int fq) const {
        const int row0 = u.pm * BM + wr * 64 + fr;
        if (sub == 0) {
#pragma unroll
            for (int ai = 0; ai < 2; ++ai)
#pragma unroll
                for (int m = 0; m < 4; ++m) {
#pragma unroll
                    for (int bj = 0; bj < 2; ++bj) {
                        const bf16_t* gp = P + (size_t)(row0 + ai * HALF + m * 16) * NPJ + PC_F + u.pn * BM + bj * HALF + wc * 32 + 8 * fq;
                        const u32x4 ga = *(const u32x4*)gp, gh = *(const u32x4*)(gp + 1024);
#pragma unroll
                        for (int i = 0; i < 2; ++i) {
                            acc[ai][bj][m][0][2 * i] *= bflo(ga[i]) * __builtin_amdgcn_rcpf(bflo(gh[i])); acc[ai][bj][m][0][2 * i + 1] *= bfhi(ga[i]) * __builtin_amdgcn_rcpf(bfhi(gh[i]));
                            acc[ai][bj][m][1][2 * i] *= bflo(ga[2 + i]) * __builtin_amdgcn_rcpf(bflo(gh[2 + i])); acc[ai][bj][m][1][2 * i + 1] *= bfhi(ga[2 + i]) * __builtin_amdgcn_rcpf(bfhi(gh[2 + i]));
                        }
                    }
                    asm volatile("" ::: "memory");
                }
        } else {
#pragma unroll
            for (int ai = 0; ai < 2; ++ai)
#pragma unroll
                for (int m = 0; m < 4; ++m) {
#pragma unroll
                    for (int bj = 0; bj < 2; ++bj) {
                        const int row = row0 + ai * HALF + m * 16, c = u.pn * BM + bj * HALF + wc * 32 + 8 * fq;
                        const u32x4 gh = *(const u32x4*)(P + (size_t)row * NPJ + PC_QH + c);
                        f32x4 v0 = acc[ai][bj][m][0], v1 = acc[ai][bj][m][1];
#pragma unroll
                        for (int i = 0; i < 2; ++i) { v0[2 * i] *= bflo(gh[i]); v0[2 * i + 1] *= bfhi(gh[i]); v1[2 * i] *= bflo(gh[2 + i]); v1[2 * i + 1] *= bfhi(gh[2 + i]); }
                        *(u32x4*)(O + (size_t)row * D + c) = pack8(v0, v1);
                    }
                    asm volatile("" ::: "memory");
                }
        }
    }
};
}

constexpr int NWAVES = 8, NTHR = 512;
constexpr int LDS_BYTES = 147456;
struct Params { const float* in[21]; float* out; unsigned char* ws; float inv_freq[8]; int ph_lo, ph_hi; };
enum { I_X = 0, I_LN1G, I_LN1B, I_F1W1, I_F1W3, I_F1W2, I_LN2G, I_LN2B, I_WIN, I_BIN, I_SINKS, I_LBL, I_NORMG, I_WPA, I_WPH, I_WOUT, I_LN3G, I_LN3B, I_F2W1, I_F2W3, I_F2W2 };

__device__ __forceinline__ float wave_sum(float v) {
#pragma unroll
    for (int o = 1; o < 64; o <<= 1) v += __shfl_xor(v, o);
    return v;
}
__device__ __forceinline__ int dst_row(int mode, int c) {
    if (mode == 0) return c;
    if (mode == 1) return (c >> 7) * 256 + (c & 127);
    if (mode == 2) return (c >> 7) * 256 + 128 + (c & 127);
    if (c < 1024) return PC_Q + c;
    if (c < 1280) return PC_K + (c - 1024);
    if (c < 1536) return PC_V + (c - 1280);
    if (c < 2560) return PC_F + (c - 1536);
    if (c < 3584) return PC_QH + (c - 2560);
    if (c < 4608) return PC_I + (c - 3584);
    return c;
}
__device__ __forceinline__ void transpose_item(const float* W, int K, int N, bf16_t* WT, int ldt, int kofs, int mode, LAS float* scr, int item, int lane) {
    const int nblk = N / 32, kb = item / nblk, nb = item % nblk, k0 = 64 * kb, n0 = 32 * nb;
#pragma unroll 8
    for (int i = 0; i < 32; ++i) { const int kk = 2 * i + (lane >> 5); scr[kk * 33 + (lane & 31)] = W[(size_t)(k0 + kk) * N + n0 + (lane & 31)]; }
    asm volatile("s_waitcnt lgkmcnt(0)" ::: "memory");
    const int c = lane & 7; const int r0 = dst_row(mode, n0);
#pragma unroll
    for (int j = 0; j < 4; ++j) { const int n = (lane >> 3) + 8 * j; const LAS float* s = scr + (8 * c) * 33 + n;
        u32x4 o; o.x = cvt_pk_bf16(s[0 * 33], s[1 * 33]); o.y = cvt_pk_bf16(s[2 * 33], s[3 * 33]); o.z = cvt_pk_bf16(s[4 * 33], s[5 * 33]); o.w = cvt_pk_bf16(s[6 * 33], s[7 * 33]);
        *(u32x4*)(WT + (size_t)(r0 + n) * ldt + kofs + k0 + 8 * c) = o; }
    asm volatile("s_waitcnt lgkmcnt(0)" ::: "memory");
}
__device__ __forceinline__ void ln_row(float* yrow, bf16_t* brow, const float* g, const float* bt, int lane) {
    f32x4* xr = (f32x4*)yrow + lane;
    f32x4 v[4]; float s = 0.f;
#pragma unroll
    for (int j = 0; j < 4; ++j) { v[j] = xr[64 * j]; s += (v[j][0] + v[j][1]) + (v[j][2] + v[j][3]); }
    const float mean = wave_sum(s) * (1.f / D); float s2 = 0.f;
#pragma unroll
    for (int j = 0; j < 4; ++j) { v[j] = v[j] - mean; s2 += (v[j][0] * v[j][0] + v[j][1] * v[j][1]) + (v[j][2] * v[j][2] + v[j][3] * v[j][3]); }
    const float rstd = 1.f / sqrtf(wave_sum(s2) * (1.f / D) + LN_EPS);
#pragma unroll
    for (int j = 0; j < 4; ++j) {
        const f32x4 gg = ((const f32x4*)g)[lane + 64 * j], bb = ((const f32x4*)bt)[lane + 64 * j];
        const f32x4 o = v[j] * rstd * gg + bb;
        xr[64 * j] = o;
        if (brow) { u32x2 w; w.x = cvt_pk_bf16(o[0], o[1]); w.y = cvt_pk_bf16(o[2], o[3]); ((u32x2*)brow)[lane + 64 * j] = w; }
    }
}

__device__ __forceinline__ void attn_unit(int b, int blk, int kvh, bf16_t* P, const float* sinks, LAS unsigned char* lds) {
    const int tid = threadIdx.x, lane = tid & 63, w = __builtin_amdgcn_readfirstlane(tid >> 6), fr = lane & 15, fq = lane >> 4;
    LAS bf16_t* Ks = (LAS bf16_t*)lds;
    LAS bf16_t* Vt = (LAS bf16_t*)(lds + 36864);
    const size_t row0 = (size_t)b * SEQ + (size_t)blk * 128;
#pragma unroll
    for (int i = 0; i < 4; ++i) {
        const int v = tid + 512 * i, kk = v >> 3, c8 = v & 7;
        u32x4 kx = (u32x4){0u, 0u, 0u, 0u}, vx = kx;
        if (blk > 0 || kk >= 128) { const bf16_t* rp = P + (row0 + kk - 128) * NPJ + kvh * 64 + c8 * 8; kx = *(const u32x4*)(rp + PC_K); vx = *(const u32x4*)(rp + PC_V); }
        *(LAS u32x4*)(Ks + kk * 72 + c8 * 8) = kx;
#pragma unroll
        for (int j = 0; j < 8; ++j) Vt[(c8 * 8 + j) * 260 + kk] = (bf16_t)(vx[j >> 1] >> (16 * (j & 1)));
    }
    __syncthreads();
    const int g = w >> 1, half = w & 1, hq = kvh * 4 + g;
    const float sink = sinks[hq];
    for (int mi = 0; mi < 4; ++mi) {
        const int t0 = 64 * half + 16 * mi;
        const bf16_t* qp = P + (row0 + t0 + fr) * NPJ + PC_Q + hq * 64 + fq * 8;
        const bf16x8 q0 = *(const bf16x8*)qp, q1 = *(const bf16x8*)(qp + 32);
        f32x4 s[12];
#pragma unroll
        for (int kt = 0; kt < 3; ++kt)
#pragma unroll
            for (int nt = 0; nt < 4; ++nt) {
                const int kk0 = 64 * (half + kt) + 16 * nt;
                const bf16x8 a0 = *(const LAS bf16x8*)(Ks + (kk0 + fr) * 72 + fq * 8), a1 = *(const LAS bf16x8*)(Ks + (kk0 + fr) * 72 + 32 + fq * 8);
                f32x4 a = (f32x4){0.f, 0.f, 0.f, 0.f};
                a = __builtin_amdgcn_mfma_f32_16x16x32_bf16(a0, q0, a, 0, 0, 0);
                a = __builtin_amdgcn_mfma_f32_16x16x32_bf16(a1, q1, a, 0, 0, 0);
                s[kt * 4 + nt] = a;
            }
        const int t = t0 + fr;
        float mx = -1e30f;
#pragma unroll
        for (int kt = 0; kt < 3; ++kt)
#pragma unroll
            for (int nt = 0; nt < 4; ++nt)
#pragma unroll
                for (int j = 0; j < 4; ++j) {
                    const int kk = 64 * (half + kt) + 16 * nt + 4 * fq + j, dist = t + 128 - kk;
                    const bool ok = dist >= 0 && dist < 128 && (blk > 0 || kk >= 128);
                    const float sv = ok ? s[kt * 4 + nt][j] : -1e30f; s[kt * 4 + nt][j] = sv; mx = fmaxf(mx, sv);
                }
        mx = fmaxf(mx, __shfl_xor(mx, 16)); mx = fmaxf(mx, __shfl_xor(mx, 32)); mx = fmaxf(mx, sink);
        float sum = 0.f;
#pragma unroll
        for (int i = 0; i < 12; ++i)
#pragma unroll
            for (int j = 0; j < 4; ++j) { const float p = __expf(s[i][j] - mx); s[i][j] = p; sum += p; }
        sum += __shfl_xor(sum, 16); sum += __shfl_xor(sum, 32);
        const float inv = 1.0f / (sum + __expf(sink - mx));
        f32x4 O[4];
#pragma unroll
        for (int dt = 0; dt < 4; ++dt) O[dt] = (f32x4){0.f, 0.f, 0.f, 0.f};
#pragma unroll
        for (int kt = 0; kt < 3; ++kt)
#pragma unroll
            for (int np = 0; np < 2; ++np) {
                const f32x4 pa = s[kt * 4 + 2 * np], pb = s[kt * 4 + 2 * np + 1];
                const u32x4 pw = pg8::pack8(pa, pb);
                const bf16x8 pf = __builtin_bit_cast(bf16x8, pw);
                const int kb = 64 * (half + kt) + 32 * np;
#pragma unroll
                for (int dt = 0; dt < 4; ++dt) {
                    const LAS bf16_t* vp = Vt + (16 * dt + fr) * 260 + kb + 4 * fq;
                    const u32x2 lo = *(const LAS u32x2*)vp, hi = *(const LAS u32x2*)(vp + 16);
                    const u32x4 vw = (u32x4){lo.x, lo.y, hi.x, hi.y};
                    O[dt] = __builtin_amdgcn_mfma_f32_16x16x32_bf16(pf, __builtin_bit_cast(bf16x8, vw), O[dt], 0, 0, 0);
                }
            }
#pragma unroll
        for (int j = 0; j < 4; ++j) {
            const float iq = __shfl(inv, 4 * fq + j);
            bf16_t* op = P + (row0 + t0 + 4 * fq + j) * NPJ + PC_Q + hq * 64 + fr;
#pragma unroll
            for (int dt = 0; dt < 4; ++dt) op[16 * dt] = (bf16_t)(cvt_pk_bf16(O[dt][j] * iq, 0.f) & 0xffffu);
        }
    }
    __syncthreads();
}

__device__ __forceinline__ void hgrn_unit(int b, int h, bf16_t* P, const float* norm_g, LAS unsigned char* lds) {
    const int tid = threadIdx.x, lane = tid & 63, w = __builtin_amdgcn_readfirstlane(tid >> 6), fr = lane & 15, fq = lane >> 4;
    const int tq = tid >> 7, d = tid & 127;
    LAS bf16_t* QD = (LAS bf16_t*)(lds);
    LAS bf16_t* KI = (LAS bf16_t*)(lds + 17408);
    LAS bf16_t* KET = (LAS bf16_t*)(lds + 34816);
    LAS bf16_t* VT = (LAS bf16_t*)(lds + 53248);
    LAS bf16_t* SC = (LAS bf16_t*)(lds + 71680);
    LAS bf16_t* ST = (LAS bf16_t*)(lds + 80896);
    LAS float* SEG = (LAS float*)(lds + 115712);
    LAS float* DEC = (LAS float*)(lds + 117760);
    LAS float* SS = (LAS float*)(lds + 118272);
    for (int i = tid; i < 34816 / 4; i += NTHR) ((LAS unsigned*)ST)[i] = 0u;
    f32x4 S[8];
#pragma unroll
    for (int i = 0; i < 8; ++i) S[i] = (f32x4){0.f, 0.f, 0.f, 0.f};
    const size_t rowbase = (size_t)b * SEQ;
    const bf16_t* pin = P + (rowbase + 16 * tq) * NPJ + h * 128 + d;
    unsigned short qv[16], gv[16], vv[16];
#pragma unroll
    for (int i = 0; i < 16; ++i) { const bf16_t* r = pin + (size_t)i * NPJ; vv[i] = r[PC_I]; gv[i] = r[PC_F]; qv[i] = r[PC_QH]; }
    const int ti = w & 3, eh = w >> 2;
    float ng[4];
#pragma unroll
    for (int et = 0; et < 4; ++et) ng[et] = norm_g[16 * (4 * eh + et) + fr];
    for (int c = 0; c < 128; ++c) {
        float run = 0.f;
#pragma unroll
        for (int i = 0; i < 16; ++i) run += bf2f(gv[i]);
        SEG[tq * 128 + d] = run;
        __syncthreads();
        const float s0 = SEG[d], s1 = SEG[128 + d], s2 = SEG[256 + d], s3 = SEG[384 + d];
        const float glast = (s0 + s1) + (s2 + s3);
        float gc = tq == 0 ? 0.f : tq == 1 ? s0 : tq == 2 ? s0 + s1 : (s0 + s1) + s2;
        const float decay = __expf(glast);
        if (tq == 0) DEC[d] = decay;
        unsigned kew[8], vw[8];
#pragma unroll
        for (int i = 0; i < 16; i += 2) {
            float ke2[2];
#pragma unroll
            for (int z = 0; z < 2; ++z) {
                const float gg = bf2f(gv[i + z]); gc += gg;
                const float eg = __expf(gc), einv = __builtin_amdgcn_rcpf(eg), kk = 1.0f - __expf(gg), ki = kk * einv;
                const int t = 16 * tq + i + z;
                QD[t * 136 + d] = (bf16_t)(cvt_pk_bf16(bf2f(qv[i + z]) * eg, 0.f) & 0xffffu);
                KI[t * 136 + d] = (bf16_t)(cvt_pk_bf16(ki, 0.f) & 0xffffu);
                ke2[z] = ki * decay;
            }
            kew[i >> 1] = cvt_pk_bf16(ke2[0], ke2[1]);
            vw[i >> 1] = (unsigned)vv[i] | ((unsigned)vv[i + 1] << 16);
        }
        *(LAS u32x4*)(KET + d * 72 + 16 * tq) = (u32x4){kew[0], kew[1], kew[2], kew[3]};
        *(LAS u32x4*)(KET + d * 72 + 16 * tq + 8) = (u32x4){kew[4], kew[5], kew[6], kew[7]};
        *(LAS u32x4*)(VT + d * 72 + 16 * tq) = (u32x4){vw[0], vw[1], vw[2], vw[3]};
        *(LAS u32x4*)(VT + d * 72 + 16 * tq + 8) = (u32x4){vw[4], vw[5], vw[6], vw[7]};
        if (c + 1 < 128) {
            const bf16_t* pn = pin + (size_t)(c + 1) * 64 * NPJ;
#pragma unroll
            for (int i = 0; i < 16; ++i) { const bf16_t* r = pn + (size_t)i * NPJ; vv[i] = r[PC_I]; gv[i] = r[PC_F]; qv[i] = r[PC_QH]; }
        }
        __syncthreads();
        {
            const int si = w & 3;
#pragma unroll
            for (int z = 0; z < 2; ++z) {
                const int tj = 2 * (w >> 2) + z;
                f32x4 a = (f32x4){0.f, 0.f, 0.f, 0.f};
                if (si <= tj) {
#pragma unroll
                    for (int ks = 0; ks < 4; ++ks) {
                        const bf16x8 ka = *(const LAS bf16x8*)(KI + (16 * si + fr) * 136 + ks * 32 + fq * 8);
                        const bf16x8 qb = *(const LAS bf16x8*)(QD + (16 * tj + fr) * 136 + ks * 32 + fq * 8);
                        a = __builtin_amdgcn_mfma_f32_16x16x32_bf16(ka, qb, a, 0, 0, 0);
                    }
                    const int tt = 16 * tj + fr;
#pragma unroll
                    for (int j = 0; j < 4; ++j) if (16 * si + 4 * fq + j > tt) a[j] = 0.f;
                }
                u32x2 o; o.x = cvt_pk_bf16(a[0], a[1]); o.y = cvt_pk_bf16(a[2], a[3]);
                *(LAS u32x2*)(SC + (16 * tj + fr) * 72 + 16 * si + 4 * fq) = o;
            }
        }
        unsigned short ogv[4][4];
        bf16_t* orow = P + (rowbase + (size_t)c * 64 + 16 * ti + 4 * fq) * NPJ + h * 128 + 64 * eh + fr;
#pragma unroll
        for (int j = 0; j < 4; ++j)
#pragma unroll
            for (int et = 0; et < 4; ++et) ogv[j][et] = orow[(size_t)j * NPJ + PC_OG + 16 * et];
        __syncthreads();
        f32x4 o[4];
#pragma unroll
        for (int et = 0; et < 4; ++et) {
            f32x4 a = (f32x4){0.f, 0.f, 0.f, 0.f};
            const int e = 16 * (4 * eh + et) + fr;
#pragma unroll
            for (int ks = 0; ks < 2; ++ks) {
                const bf16x8 sa = *(const LAS bf16x8*)(SC + (16 * ti + fr) * 72 + ks * 32 + fq * 8);
                const bf16x8 vb = *(const LAS bf16x8*)(VT + e * 72 + ks * 32 + fq * 8);
                a = __builtin_amdgcn_mfma_f32_16x16x32_bf16(sa, vb, a, 0, 0, 0);
            }
#pragma unroll
            for (int ks = 0; ks < 4; ++ks) {
                const bf16x8 qa = *(const LAS bf16x8*)(QD + (16 * ti + fr) * 136 + ks * 32 + fq * 8);
                const bf16x8 sb = *(const LAS bf16x8*)(ST + e * 136 + ks * 32 + fq * 8);
                a = __builtin_amdgcn_mfma_f32_16x16x32_bf16(qa, sb, a, 0, 0, 0);
            }
            o[et] = a;
        }
#pragma unroll
        for (int j = 0; j < 4; ++j) {
            float q = (o[0][j] * o[0][j] + o[1][j] * o[1][j]) + (o[2][j] * o[2][j] + o[3][j] * o[3][j]);
            q += __shfl_xor(q, 1); q += __shfl_xor(q, 2); q += __shfl_xor(q, 4); q += __shfl_xor(q, 8);
            if (fr == 0) SS[(16 * ti + 4 * fq + j) * 2 + eh] = q;
        }
        {
            float dc[4];
#pragma unroll
            for (int j = 0; j < 4; ++j) dc[j] = DEC[16 * w + 4 * fq + j];
            const bf16x8 ka0 = *(const LAS bf16x8*)(KET + (16 * w + fr) * 72 + fq * 8), ka1 = *(const LAS bf16x8*)(KET + (16 * w + fr) * 72 + 32 + fq * 8);
#pragma unroll
            for (int et = 0; et < 8; ++et) {
                f32x4 a = S[et];
#pragma unroll
                for (int j = 0; j < 4; ++j) a[j] *= dc[j];
                const bf16x8 vb0 = *(const LAS bf16x8*)(VT + (16 * et + fr) * 72 + fq * 8), vb1 = *(const LAS bf16x8*)(VT + (16 * et + fr) * 72 + 32 + fq * 8);
                a = __builtin_amdgcn_mfma_f32_16x16x32_bf16(ka0, vb0, a, 0, 0, 0);
                a = __builtin_amdgcn_mfma_f32_16x16x32_bf16(ka1, vb1, a, 0, 0, 0);
                S[et] = a;
            }
        }
        __syncthreads();
#pragma unroll
        for (int et = 0; et < 8; ++et) { u32x2 sw; sw.x = cvt_pk_bf16(S[et][0], S[et][1]); sw.y = cvt_pk_bf16(S[et][2], S[et][3]);
            *(LAS u32x2*)(ST + (16 * et + fr) * 136 + 16 * w + 4 * fq) = sw; }
#pragma unroll
        for (int j = 0; j < 4; ++j) {
            const int t = 16 * ti + 4 * fq + j;
            const float r = __builtin_amdgcn_rsqf((SS[t * 2] + SS[t * 2 + 1]) * (1.0f / 128.0f) + RMS_EPS);
#pragma unroll
            for (int et = 0; et < 4; ++et) orow[(size_t)j * NPJ + PC_I + 16 * et] = (bf16_t)(cvt_pk_bf16(o[et][j] * r * ng[et] * bf2f(ogv[j][et]), 0.f) & 0xffffu);
        }
    }
    __syncthreads();
}

__global__ void __launch_bounds__(NTHR, 2) mk_fwd(Params p) {
    extern __shared__ __attribute__((aligned(16))) unsigned char lds_raw[];
    LAS unsigned char* lds = (LAS unsigned char*)lds_raw;
    const int tid = threadIdx.x, lane = tid & 63, wave = __builtin_amdgcn_readfirstlane(tid >> 6);
    const int G = gridDim.x, bx = blockIdx.x;
    const int gw = bx * NWAVES + wave, NGW = G * NWAVES;
    unsigned char* ws = p.ws;
    bf16_t* W13A = (bf16_t*)(ws + WS_W13A); bf16_t* W2A = (bf16_t*)(ws + WS_W2A); bf16_t* WIN = (bf16_t*)(ws + WS_WIN); bf16_t* WM = (bf16_t*)(ws + WS_WM);
    bf16_t* WOUT = (bf16_t*)(ws + WS_WOUT); bf16_t* W13B = (bf16_t*)(ws + WS_W13B); bf16_t* W2B = (bf16_t*)(ws + WS_W2B);
    bf16_t* XB = (bf16_t*)(ws + WS_XB); bf16_t* PJ = (bf16_t*)(ws + WS_PJ); bf16_t* HB = PJ;
    float* ROPE = (float*)(ws + WS_ROPE); float* LB = (float*)(ws + WS_LB); float* BIAS = (float*)(ws + WS_BIAS);
    float* out = p.out;
    const int lo = p.ph_lo, hi = p.ph_hi;
#ifndef PH_MASK
#define PH_MASK 0x1fff
#endif
#define IN(k) (((PH_MASK >> (k)) & 1) && lo <= (k) && (k) < hi)
#if MK_PER_PHASE
#define SEAM(k) do { } while (0)
#else
#define SEAM(k) do { if (IN(k) && IN((k) + 1)) { __threadfence(); cg::this_grid().sync(); } } while (0)
#endif

    if (IN(0)) {
        LAS float* scr = (LAS float*)(lds + wave * 16384);
        constexpr int IT_F = (D / 64) * (DFF / 32), IT_F2 = (DFF / 64) * (D / 32), IT_IN = (D / 64) * (NIN / 32), IT_SQ = (D / 64) * (D / 32);
        constexpr int NITEMS = 4 * IT_F + 2 * IT_F2 + IT_IN + 3 * IT_SQ;
        for (int it = gw; it < NITEMS; it += NGW) {
            int r = it;
            if (r < IT_F) { transpose_item(p.in[I_F1W1], D, DFF, W13A, D, 0, 1, scr, r, lane); continue; } r -= IT_F;
            if (r < IT_F) { transpose_item(p.in[I_F1W3], D, DFF, W13A, D, 0, 2, scr, r, lane); continue; } r -= IT_F;
            if (r < IT_F) { transpose_item(p.in[I_F2W1], D, DFF, W13B, D, 0, 1, scr, r, lane); continue; } r -= IT_F;
            if (r < IT_F) { transpose_item(p.in[I_F2W3], D, DFF, W13B, D, 0, 2, scr, r, lane); continue; } r -= IT_F;
            if (r < IT_F2) { transpose_item(p.in[I_F1W2], DFF, D, W2A, DFF, 0, 0, scr, r, lane); continue; } r -= IT_F2;
            if (r < IT_F2) { transpose_item(p.in[I_F2W2], DFF, D, W2B, DFF, 0, 0, scr, r, lane); continue; } r -= IT_F2;
            if (r < IT_IN) { transpose_item(p.in[I_WIN], D, NIN, WIN, D, 0, 3, scr, r, lane); continue; } r -= IT_IN;
            if (r < IT_SQ) { transpose_item(p.in[I_WPA], D, D, WM, 2 * D, 0, 0, scr, r, lane); continue; } r -= IT_SQ;
            if (r < IT_SQ) { transpose_item(p.in[I_WPH], D, D, WM, 2 * D, D, 0, scr, r, lane); continue; } r -= IT_SQ;
            transpose_item(p.in[I_WOUT], D, D, WOUT, D, 0, 0, scr, r, lane);
        }
        const int gt = bx * NTHR + tid, NGT = G * NTHR;
        for (int i = gt; i < M * D / 8; i += NGT) {
            const f32x4 a = ((const f32x4*)p.in[I_X])[2 * (size_t)i], b = ((const f32x4*)p.in[I_X])[2 * (size_t)i + 1];
            ((u32x4*)XB)[i] = pg8::pack8(a, b);
        }
        for (int i = gt; i < SEQ * 8; i += NGT) {
            const int pos = i >> 3, f = i & 7;
            const float ang = (float)pos * p.inv_freq[f];
            const double rev = (double)ang * 0.15915494309189535; const float fr_ = (float)(rev - rint(rev));
            ROPE[pos * 16 + f] = __builtin_amdgcn_cosf(fr_); ROPE[pos * 16 + 8 + f] = __builtin_amdgcn_sinf(fr_);
        }
        for (int i = gt; i < 1024; i += NGT) { const float l0 = p.in[I_LBL][i], l1 = p.in[I_LBL][1024 + i]; LB[i] = 1.0f / (1.0f + expf(l1 - l0)); }
        for (int i = gt; i < NIN; i += NGT) BIAS[dst_row(3, i)] = p.in[I_BIN][i];
    }
    SEAM(0);
    if (IN(1)) {
        pg8::Gemm g{XB, W13A, D, D, D, M, 2 * DFF, 0, 0}; pg8::StaticOrder S; S.init(M, 2 * DFF, G, bx);
        pg8::EpiSwiglu E{HB};
        pg8::gemm_phase(lds, g, S, E);
    }
    SEAM(1);
    if (IN(2)) {
        pg8::Gemm g{HB, W2A, DFF, DFF, DFF, M, D, 0, 0}; pg8::StaticOrder S; S.init(M, D, G, bx);
        pg8::EpiResid E{p.in[I_X], out, ALPHA, 0.5f};
        pg8::gemm_phase(lds, g, S, E);
    }
    SEAM(2);
    if (IN(3)) { for (int m = gw; m < M; m += NGW) ln_row(out + (size_t)m * D, XB + (size_t)m * D, p.in[I_LN1G], p.in[I_LN1B], lane); }
    SEAM(3);
    if (IN(4)) {
        pg8::Gemm g{XB, WIN, D, D, D, M, NPJ, 0, 0}; pg8::StaticOrder S; S.init(M, NPJ, G, bx);
        pg8::EpiProj E{PJ, BIAS, LB, ROPE};
        pg8::gemm_phase(lds, g, S, E);
    }
    SEAM(4);
    if (IN(5)) {
        const int NH = 64;
        if (G > NH) {
            if (bx < NH) hgrn_unit(bx >> 3, bx & 7, PJ, p.in[I_NORMG], lds);
            else for (int u = bx - NH; u < BATCH * 64 * 4; u += G - NH) attn_unit(u >> 8, (u >> 2) & 63, u & 3, PJ, p.in[I_SINKS], lds);
        } else {
            for (int u = bx; u < NH; u += G) hgrn_unit(u >> 3, u & 7, PJ, p.in[I_NORMG], lds);
            for (int u = bx; u < BATCH * 64 * 4; u += G) attn_unit(u >> 8, (u >> 2) & 63, u & 3, PJ, p.in[I_SINKS], lds);
        }
    }
    SEAM(5);
    if (IN(6)) {
        pg8::Gemm g{XB, WIN + (size_t)NPJ * D, D, D, D, M, 2 * D, 0, 0}; pg8::StaticOrder S; S.init(M, 2 * D, G, bx);
        pg8::EpiGate E{PJ, BIAS};
        pg8::gemm_phase(lds, g, S, E);
    }
    SEAM(6);
    if (IN(7)) {
        pg8::Gemm g{PJ, WM, NPJ, 2 * D, D, M, D, D * 2, D * 2}; pg8::StaticOrder S; S.init(M, D, G, bx);
        pg8::EpiMerge E{PJ, XB};
        pg8::gemm_phase(lds, g, S, E);
    }
    SEAM(7);
    if (IN(8)) {
        pg8::Gemm g{XB, WOUT, D, D, D, M, D, 0, 0}; pg8::StaticOrder S; S.init(M, D, G, bx);
        pg8::EpiResid E{out, out, ALPHA, 1.0f};
        pg8::gemm_phase(lds, g, S, E);
    }
    SEAM(8);
    if (IN(9)) { for (int m = gw; m < M; m += NGW) ln_row(out + (size_t)m * D, XB + (size_t)m * D, p.in[I_LN2G], p.in[I_LN2B], lane); }
    SEAM(9);
    if (IN(10)) {
        pg8::Gemm g{XB, W13B, D, D, D, M, 2 * DFF, 0, 0}; pg8::StaticOrder S; S.init(M, 2 * DFF, G, bx);
        pg8::EpiSwiglu E{HB};
        pg8::gemm_phase(lds, g, S, E);
    }
    SEAM(10);
    if (IN(11)) {
        pg8::Gemm g{HB, W2B, DFF, DFF, DFF, M, D, 0, 0}; pg8::StaticOrder S; S.init(M, D, G, bx);
        pg8::EpiResid E{out, out, ALPHA, 0.5f};
        pg8::gemm_phase(lds, g, S, E);
    }
    SEAM(11);
    if (IN(12)) { for (int m = gw; m < M; m += NGW) ln_row(out + (size_t)m * D, nullptr, p.in[I_LN3G], p.in[I_LN3B], lane); }
#undef IN
#undef SEAM
}

constexpr int N_PHASES = 13;

extern "C" void kernel_launch(void* const* d_in, const int* in_sizes, int n_in, void* d_out, int out_size, void* d_ws, size_t ws_size, hipStream_t stream) {
    static int grid = 0;
    if (grid == 0) {
        if (n_in != 21 || in_sizes[0] != M * D || out_size != M * D || ws_size < WS_END) {
            fprintf(stderr, "kernel_launch: unexpected shapes/workspace: n_in %d in0 %d out %d ws %zu (need %zu)\n", n_in, n_in > 0 ? in_sizes[0] : -1, out_size, ws_size, (size_t)WS_END);
            grid = -1; return; }
        int dev = 0, cus = 0, per_cu = 0;
        (void)hipGetDevice(&dev); (void)hipDeviceGetAttribute(&cus, hipDeviceAttributeMultiprocessorCount, dev);
        if (hipFuncSetAttribute((const void*)mk_fwd, hipFuncAttributeMaxDynamicSharedMemorySize, LDS_BYTES) != hipSuccess) { fprintf(stderr, "kernel_launch: hipFuncSetAttribute failed\n"); grid = -1; return; }
        if (hipOccupancyMaxActiveBlocksPerMultiprocessor(&per_cu, (const void*)mk_fwd, NTHR, LDS_BYTES) != hipSuccess || per_cu < 1) { fprintf(stderr, "kernel_launch: occupancy query says %d\n", per_cu); per_cu = 1; }
        (void)hipGetLastError();
        grid = cus * 1;
        if (grid <= 0) grid = 256;
    }
    if (grid < 0) return;
    Params p{};
    for (int i = 0; i < 21; ++i) p.in[i] = (const float*)d_in[i];
    p.out = (float*)d_out; p.ws = (unsigned char*)d_ws;
    for (int i = 0; i < 8; ++i) p.inv_freq[i] = powf(500000.0f, -(float)(2 * i) / 16.0f);
#if MK_PER_PHASE
    for (int ph = 0; ph < N_PHASES; ++ph) { p.ph_lo = ph; p.ph_hi = ph + 1; hipLaunchKernelGGL(mk_fwd, dim3(grid), dim3(NTHR), LDS_BYTES, stream, p); }
#else
    p.ph_lo = 0; p.ph_hi = N_PHASES;
    void* args[] = {&p};
    hipError_t e = hipLaunchCooperativeKernel((const void*)mk_fwd, dim3(grid), dim3(NTHR), args, LDS_BYTES, stream);
    if (e != hipSuccess) fprintf(stderr, "kernel_launch: cooperative launch failed: %s (grid %d)\n", hipGetErrorString(e), grid);
#endif
}
```

```cpp
#include <hip/hip_runtime.h>
#include <hip/hip_cooperative_groups.h>
#include <cstdio>
#include <cstdint>
#include <cmath>
namespace cg = cooperative_groups;

#ifndef MK_PER_PHASE
#define MK_PER_PHASE 0
#endif

#define LAS __attribute__((address_space(3)))
typedef unsigned short bf16_t;
typedef short bf16x8 __attribute__((ext_vector_type(8)));
typedef float f32x4 __attribute__((ext_vector_type(4)));
typedef unsigned u32x4 __attribute__((ext_vector_type(4)));
typedef unsigned u32x2 __attribute__((ext_vector_type(2)));

constexpr int D = 1024, BATCH = 8, SEQ = 8192, M = BATCH * SEQ, DFF = 2816, NPJ = 5632, NIN = 7680;
constexpr float ALPHA = 1.189207115002721f;
constexpr float LN_EPS = 1e-5f, RMS_EPS = 1e-6f;
constexpr int PC_Q = 0, PC_I = 1024, PC_F = 2048, PC_QH = 3072, PC_K = 4096, PC_V = 4352, PC_OG = 4608;

constexpr size_t MiB = 1u << 20;
constexpr size_t WS_TAB = 1 * MiB;
constexpr size_t WS_ROPE = WS_TAB, WS_LB = WS_TAB + 512 * 1024, WS_BIAS = WS_LB + 4096;
constexpr size_t WS_W13A = 2 * MiB, WS_W2A = 13 * MiB, WS_WIN = 19 * MiB, WS_WM = 34 * MiB, WS_WOUT = 38 * MiB, WS_W13B = 40 * MiB, WS_W2B = 51 * MiB;
constexpr size_t WS_XB = 64 * MiB;
constexpr size_t WS_PJ = 192 * MiB;
constexpr size_t WS_U = 896 * MiB;
constexpr size_t WS_DSEG = 912 * MiB;
constexpr size_t WS_END = 913 * MiB;

typedef float f32x2_t __attribute__((ext_vector_type(2))); typedef __bf16 bf16x2_t __attribute__((ext_vector_type(2)));
__device__ __forceinline__ unsigned cvt_pk_bf16(float lo, float hi) { f32x2_t v = {lo, hi}; bf16x2_t b = __builtin_convertvector(v, bf16x2_t); return __builtin_bit_cast(unsigned, b); }
__device__ __forceinline__ float bf2f(unsigned short v) { return __uint_as_float((unsigned)v << 16); }
__device__ __forceinline__ float bflo(unsigned v) { return __uint_as_float(v << 16); }
__device__ __forceinline__ float bfhi(unsigned v) { return __uint_as_float(v & 0xffff0000u); }
__device__ __forceinline__ float sigmoidf_(float x) { return __builtin_amdgcn_rcpf(1.0f + __expf(-x)); }
__device__ __forceinline__ float siluf_(float x) { return x * sigmoidf_(x); }

namespace pg8 {
constexpr int BM = 256, BK = 64, HALF = 128, HTB = HALF * BK * 2, STAGE_BYTES = 8 * HTB, NXCD = 8, WGM = 8;
__host__ __device__ __forceinline__ int lds_byte(int r, int c) { const int st = (r >> 4) * 2 + (c >> 5), rr = r & 15, cc = c & 31, ob = rr * 64 + cc * 2; return st * 1024 + (ob ^ (((ob >> 9) & 1) << 5)); }
__host__ __device__ __forceinline__ void stage_rc(int b, int& R, int& C) { const int st = b / 1024, sb = b % 1024, swz = sb ^ (((sb >> 9) & 1) << 5); R = (st >> 1) * 16 + swz / 64; C = (st & 1) * 32 + (swz % 64) / 2; }
__host__ __device__ __forceinline__ int perm32(int rho) { const int n = rho >> 4, i = rho & 15; return 8 * (i >> 2) + 4 * n + (i & 3); }

struct Unit { int pm, pn; };
struct Gemm { const bf16_t* A; const bf16_t* Bt; int lda, ldb, K, M, N; int subA, subB; };

struct StaticOrder {
    int nM, nN, nwg, G, c;
    __host__ __device__ void init(int M_, int N_, int G_, int c_) { nM = M_ / BM; nN = N_ / BM; nwg = nM * nN; G = G_; c = c_; }
    __host__ __device__ bool next(int i, Unit& u) const {
        const long L = (long)i * G + c; if (L >= nwg) return false;
        int wgid = (int)L; { const int q = nwg / NXCD, r = nwg % NXCD, xcd = wgid % NXCD, off = wgid / NXCD; wgid = (xcd < r ? xcd * (q + 1) : r * (q + 1) + (xcd - r) * q) + off; }
        const int nig = WGM * nN, gid = wgid / nig, fm = gid * WGM, gsz = (nM - fm) < WGM ? (nM - fm) : WGM;
        u.pm = fm + ((wgid % nig) % gsz); u.pn = (wgid % nig) / gsz; return true;
    }
};

typedef f32x4 Acc[2][2][4][2];

template <class Epi>
__device__ __forceinline__ void gemm_phase(LAS unsigned char* lds, const Gemm g, const StaticOrder& S, const Epi& E) {
    const int tid = threadIdx.x, wid = __builtin_amdgcn_readfirstlane(tid >> 6), lane = tid & 63, wr = wid >> 2, wc = wid & 3, fr = lane & 15, fq = lane >> 4;
    const int K = g.K, nt = K / BK;
    unsigned voffA[2], voffB[2];
#pragma unroll
    for (int i = 0; i < 2; ++i) { int R, C; stage_rc(tid * 16 + i * 8192, R, C); const int Rb = (R & ~31) + perm32(R & 31);
        voffA[i] = (unsigned)(R * g.lda + C) * 2u; voffB[i] = (unsigned)(Rb * g.ldb + C) * 2u; }
    const size_t kstep = (size_t)(BK * 2);
    const size_t hstepA = (size_t)HALF * g.lda * 2, hstepB = (size_t)HALF * g.ldb * 2;
    const size_t tstepA = 2 * hstepA, tstepB = 2 * hstepB;
    const unsigned ldsw = (unsigned)wid * 1024u;
    const int aoff = lds_byte(wr * 64 + fr, fq * 8), boff = lds_byte(wc * 32 + fr, fq * 8);
#define PG8_SA(b, h) (((b) * 2 + (h)) * HTB)
#define PG8_SB(b, h) ((4 + (b) * 2 + (h)) * HTB)
#define PG8_STAGE(bufoff, gbase, voff) do { _Pragma("unroll") for (int _i = 0; _i < 2; ++_i) \
        __builtin_amdgcn_global_load_lds((const unsigned*)((const char*)(gbase) + (voff)[_i]), (LAS unsigned*)(lds + (bufoff) + ldsw + _i * 8192), 16, 0, 0); } while (0)
#define PG8_LDA(dst, b, h) do { _Pragma("unroll") for (int m = 0; m < 4; ++m) _Pragma("unroll") for (int k = 0; k < 2; ++k) dst[m][k] = *(const LAS bf16x8*)(lds + PG8_SA(b, h) + aoff + m * 2048 + k * 1024); } while (0)
#define PG8_LDB(dst, b, h) do { _Pragma("unroll") for (int n = 0; n < 2; ++n) _Pragma("unroll") for (int k = 0; k < 2; ++k) dst[n][k] = *(const LAS bf16x8*)(lds + PG8_SB(b, h) + boff + n * 2048 + k * 1024); } while (0)
#define PG8_MMA(ai, bj, At, Bt) do { __builtin_amdgcn_s_setprio(1); _Pragma("unroll") for (int m = 0; m < 4; ++m) _Pragma("unroll") for (int n = 0; n < 2; ++n) _Pragma("unroll") for (int k = 0; k < 2; ++k) \
        acc[ai][bj][m][n] = __builtin_amdgcn_mfma_f32_16x16x32_bf16(Bt[n][k], At[m][k], acc[ai][bj][m][n], 0, 0, 0); __builtin_amdgcn_s_setprio(0); } while (0)
#define PG8_WAIT_V(n) asm volatile("s_waitcnt vmcnt(" #n ")" ::: "memory")
#define PG8_WAIT_L(n) asm volatile("s_waitcnt lgkmcnt(" #n ")" ::: "memory")
#define PG8_BAR __builtin_amdgcn_s_barrier()
#define PG8_SCHED __builtin_amdgcn_sched_barrier(0)
    constexpr int NSUB = Epi::NSUB;
    Unit cur, nxt; int ui = 0, csub = 0, nsub = 0;
    if (!S.next(0, cur)) return;
    Acc acc;
#pragma unroll
    for (int a = 0; a < 2; ++a)
#pragma unroll
        for (int b = 0; b < 2; ++b)
#pragma unroll
            for (int m = 0; m < 4; ++m)
#pragma unroll
                for (int n = 0; n < 2; ++n) acc[a][b][m][n] = (f32x4){0.f, 0.f, 0.f, 0.f};
    bf16x8 At[4][2], B0[2][2], B1[2][2];
    const char* cA = (const char*)g.A + (size_t)cur.pm * tstepA; const char* cB = (const char*)g.Bt + (size_t)cur.pn * tstepB;
    PG8_STAGE(PG8_SB(0, 0), cB, voffB); PG8_STAGE(PG8_SB(0, 1), cB + hstepB, voffB); PG8_STAGE(PG8_SA(0, 0), cA, voffA); PG8_STAGE(PG8_SA(0, 1), cA + hstepA, voffA);
    if (wr == 1) PG8_BAR;
    PG8_WAIT_V(2); PG8_BAR;
    PG8_STAGE(PG8_SB(1, 0), cB + kstep, voffB); PG8_STAGE(PG8_SA(1, 0), cA + kstep, voffA); PG8_STAGE(PG8_SB(1, 1), cB + hstepB + kstep, voffB);
    PG8_WAIT_V(6); PG8_BAR;
    for (;;) {
        nsub = (ui + 1) % NSUB;
        const bool has_next = S.next((ui + 1) / NSUB, nxt);
        const char* nA = has_next ? (const char*)g.A + (size_t)nxt.pm * tstepA + (size_t)nsub * g.subA : cA; const char* nB = has_next ? (const char*)g.Bt + (size_t)nxt.pn * tstepB + (size_t)nsub * g.subB : cB;
        for (int t = 0; t < nt; t += 2) {
            const bool last = (t == nt - 2);
            const char* a1 = cA + (size_t)(t + 1) * kstep;
            const char* a2 = last ? nA : cA + (size_t)(t + 2) * kstep; const char* b2 = last ? nB : cB + (size_t)(t + 2) * kstep;
            const char* a3 = a2 + kstep; const char* b3 = b2 + kstep;
            PG8_LDB(B0, 0, 0); PG8_LDB(B1, 0, 1); PG8_SCHED; PG8_LDA(At, 0, 0); PG8_STAGE(PG8_SA(1, 1), a1 + hstepA, voffA);
            PG8_WAIT_V(8); PG8_WAIT_L(0); PG8_BAR; PG8_MMA(0, 0, At, B0); PG8_MMA(0, 1, At, B1); PG8_BAR; PG8_SCHED;
            PG8_LDA(At, 0, 1); PG8_STAGE(PG8_SB(0, 0), b2, voffB); PG8_STAGE(PG8_SB(0, 1), b2 + hstepB, voffB); PG8_STAGE(PG8_SA(0, 0), a2, voffA);
            PG8_WAIT_V(8); PG8_WAIT_L(0); PG8_BAR; PG8_MMA(1, 0, At, B0); PG8_MMA(1, 1, At, B1); PG8_BAR; PG8_SCHED;
            PG8_LDB(B0, 1, 0); PG8_LDB(B1, 1, 1); PG8_SCHED; PG8_LDA(At, 1, 0); PG8_STAGE(PG8_SA(0, 1), a2 + hstepA, voffA);
            PG8_WAIT_V(8); PG8_WAIT_L(0); PG8_BAR; PG8_MMA(0, 0, At, B0); PG8_MMA(0, 1, At, B1); PG8_BAR; PG8_SCHED;
            PG8_LDA(At, 1, 1); PG8_STAGE(PG8_SB(1, 0), b3, voffB); PG8_STAGE(PG8_SB(1, 1), b3 + hstepB, voffB); PG8_STAGE(PG8_SA(1, 0), a3, voffA);
            PG8_WAIT_V(8); PG8_WAIT_L(0); PG8_BAR; PG8_MMA(1, 0, At, B0); PG8_MMA(1, 1, At, B1); PG8_BAR; PG8_SCHED;
        }
        if (wr == 0) PG8_BAR;
        E(acc, cur, csub, wr, wc, fr, fq);
        if (!has_next) break;
        if (NSUB == 1 || nsub == 0) {
#pragma unroll
        for (int a = 0; a < 2; ++a)
#pragma unroll
            for (int b = 0; b < 2; ++b)
#pragma unroll
                for (int m = 0; m < 4; ++m)
#pragma unroll
                    for (int n = 0; n < 2; ++n) acc[a][b][m][n] = (f32x4){0.f, 0.f, 0.f, 0.f};
        }
        cur = nxt; csub = nsub; cA = nA; cB = nB; ++ui;
        if (wr == 1) PG8_BAR;
    }
    PG8_WAIT_V(0);
    PG8_BAR;
#undef PG8_SA
#undef PG8_SB
#undef PG8_STAGE
#undef PG8_LDA
#undef PG8_LDB
#undef PG8_MMA
#undef PG8_WAIT_V
#undef PG8_WAIT_L
#undef PG8_BAR
#undef PG8_SCHED
}

__device__ __forceinline__ u32x4 pack8(const f32x4 a, const f32x4 b) { u32x4 w; w.x = cvt_pk_bf16(a[0], a[1]); w.y = cvt_pk_bf16(a[2], a[3]); w.z = cvt_pk_bf16(b[0], b[1]); w.w = cvt_pk_bf16(b[2], b[3]); return w; }

struct EpiSwiglu {
    static constexpr int NSUB = 1;
    bf16_t* H;
    __device__ __forceinline__ void operator()(Acc& acc, const Unit& u, int sub, int wr, int wc, int fr, int fq) const {
        const int row0 = u.pm * BM + wr * 64 + fr, col = u.pn * 128 + wc * 32 + 8 * fq;
#pragma unroll
        for (int ai = 0; ai < 2; ++ai)
#pragma unroll
            for (int m = 0; m < 4; ++m) {
                f32x4 h0, h1;
#pragma unroll
                for (int i = 0; i < 4; ++i) { h0[i] = siluf_(acc[ai][0][m][0][i]) * acc[ai][1][m][0][i]; h1[i] = siluf_(acc[ai][0][m][1][i]) * acc[ai][1][m][1][i]; }
                *(u32x4*)(H + (size_t)(row0 + ai * HALF + m * 16) * DFF + col) = pack8(h0, h1);
            }
    }
};
struct EpiResid {
    static constexpr int NSUB = 1;
    const float* res; float* out; float alpha, s;
    __device__ __forceinline__ void operator()(Acc& acc, const Unit& u, int sub, int wr, int wc, int fr, int fq) const {
        const int row0 = u.pm * BM + wr * 64 + fr, col0 = u.pn * BM + wc * 32 + 8 * fq;
#pragma unroll
        for (int ai = 0; ai < 2; ++ai)
#pragma unroll
            for (int m = 0; m < 4; ++m) {
#pragma unroll
                for (int bj = 0; bj < 2; ++bj) { const size_t off = (size_t)(row0 + ai * HALF + m * 16) * D + col0 + bj * HALF;
                    const f32x4 r0 = *(const f32x4*)(res + off), r1 = *(const f32x4*)(res + off + 4);
                    *(f32x4*)(out + off) = r0 * alpha + acc[ai][bj][m][0] * s; *(f32x4*)(out + off + 4) = r1 * alpha + acc[ai][bj][m][1] * s; }
                asm volatile("" ::: "memory");
            }
    }
};
struct EpiProj {
    static constexpr int NSUB = 1;
    bf16_t* P; const float* bias; const float* lb; const float* rope;
    __device__ __forceinline__ void operator()(Acc& acc, const Unit& u, int sub, int wr, int wc, int fr, int fq) const {
        const int row0 = u.pm * BM + wr * 64 + fr; const int pn = u.pn;
        const int kind = pn < 4 ? 0 : pn < 8 ? 1 : pn < 12 ? 2 : pn < 16 ? 3 : pn == 16 ? 4 : pn == 17 ? 1 : 3;
#pragma unroll
        for (int bj = 0; bj < 2; ++bj) {
            const int c = pn * BM + bj * HALF + wc * 32 + 8 * fq;
            const f32x4 b0 = *(const f32x4*)(bias + c), b1 = *(const f32x4*)(bias + c + 4);
            f32x4 l0 = (f32x4){0.f, 0.f, 0.f, 0.f}, l1 = l0;
            if (kind == 2) { l0 = *(const f32x4*)(lb + (c - PC_F)); l1 = *(const f32x4*)(lb + (c - PC_F) + 4); }
#pragma unroll
            for (int ai = 0; ai < 2; ++ai)
#pragma unroll
                for (int m = 0; m < 4; ++m) {
                    const int row = row0 + ai * HALF + m * 16;
                    f32x4 v0 = acc[ai][bj][m][0] + b0, v1 = acc[ai][bj][m][1] + b1;
                    if (kind == 0 || kind == 4) {
                        f32x4 p0, p1;
#pragma unroll
                        for (int i = 0; i < 4; ++i) { p0[i] = __shfl_xor(v0[i], 16); p1[i] = __shfl_xor(v1[i], 16); }
                        if ((wc & 1) == 0 && fq < 2) {
                            const float* tb = rope + (size_t)(row & (SEQ - 1)) * 16;
                            const f32x4 c0 = *(const f32x4*)(tb), c1 = *(const f32x4*)(tb + 4), s0 = *(const f32x4*)(tb + 8), s1 = *(const f32x4*)(tb + 12);
                            const float sg = fq == 0 ? -1.f : 1.f;
                            v0 = v0 * c0 + p0 * s0 * sg; v1 = v1 * c1 + p1 * s1 * sg;
                        }
                        if (kind == 0) { v0 = v0 * 0.125f; v1 = v1 * 0.125f; }
                    } else if (kind == 2) {
#pragma unroll
                        for (int i = 0; i < 4; ++i) { v0[i] = __logf(l0[i] + (1.f - l0[i]) * sigmoidf_(v0[i])); v1[i] = __logf(l1[i] + (1.f - l1[i]) * sigmoidf_(v1[i])); }
                    } else if (kind == 3) {
#pragma unroll
                        for (int i = 0; i < 4; ++i) { v0[i] = siluf_(v0[i]); v1[i] = siluf_(v1[i]); }
                    }
                    *(u32x4*)(P + (size_t)row * NPJ + c) = pack8(v0, v1);
                }
        }
    }
};
struct EpiGate {
    static constexpr int NSUB = 1;
    bf16_t* P; const float* bias;
    __device__ __forceinline__ void operator()(Acc& acc, const Unit& u, int sub, int wr, int wc, int fr, int fq) const {
        const int row0 = u.pm * BM + wr * 64 + fr;
#pragma unroll
        for (int bj = 0; bj < 2; ++bj) {
            const int c = u.pn * BM + bj * HALF + wc * 32 + 8 * fq;
            const f32x4 b0 = *(const f32x4*)(bias + NPJ + c), b1 = *(const f32x4*)(bias + NPJ + c + 4);
#pragma unroll
            for (int ai = 0; ai < 2; ++ai)
#pragma unroll
                for (int m = 0; m < 4; ++m) {
                    f32x4 v0 = acc[ai][bj][m][0] + b0, v1 = acc[ai][bj][m][1] + b1;
#pragma unroll
                    for (int i = 0; i < 4; ++i) { v0[i] = sigmoidf_(v0[i]); v1[i] = sigmoidf_(v1[i]); }
                    *(u32x4*)(P + (size_t)(row0 + ai * HALF + m * 16) * NPJ + PC_F + c) = pack8(v0, v1);
                }
        }
    }
};
struct EpiMerge {
    static constexpr int NSUB = 2;
    const bf16_t* P; bf16_t* O;
    __device__ __forceinline__ void operator()(Acc& acc, const Unit& u, int sub, int wr, int wc, int fr, int fq) const {
        const int row0 = u.pm * BM + wr * 64 + fr;
        if (sub == 0) {
#pragma unroll
            for (int ai = 0; ai < 2; ++ai)
#pragma unroll
                for (int m = 0; m < 4; ++m) {
#pragma unroll
                    for (int bj = 0; bj < 2; ++bj) {
                        const bf16_t* gp = P + (size_t)(row0 + ai * HALF + m * 16) * NPJ + PC_F + u.pn * BM + bj * HALF + wc * 32 + 8 * fq;
                        const u32x4 ga = *(const u32x4*)gp, gh = *(const u32x4*)(gp + 1024);
#pragma unroll
                        for (int i = 0; i < 2; ++i) {
                            acc[ai][bj][m][0][2 * i] *= bflo(ga[i]) * __builtin_amdgcn_rcpf(bflo(gh[i])); acc[ai][bj][m][0][2 * i + 1] *= bfhi(ga[i]) * __builtin_amdgcn_rcpf(bfhi(gh[i]));
                            acc[ai][bj][m][1][2 * i] *= bflo(ga[2 + i]) * __builtin_amdgcn_rcpf(bflo(gh[2 + i])); acc[ai][bj][m][1][2 * i + 1] *= bfhi(ga[2 + i]) * __builtin_amdgcn_rcpf(bfhi(gh[2 + i]));
                        }
                    }
                    asm volatile("" ::: "memory");
                }
        } else {
#pragma unroll
            for (int ai = 0; ai < 2; ++ai)
#pragma unroll
                for (int m = 0; m < 4; ++m) {
#pragma unroll
                    for (int bj = 0; bj < 2; ++bj) {
                        const int row = row0 + ai * HALF + m * 16, c = u.pn * BM + bj * HALF + wc * 32 + 8 * fq;
                        const u32x4 gh = *(const u32x4*)(P + (size_t)row * NPJ + PC_QH + c);
                        f32x4 v0 = acc[ai][bj][m][0], v1 = acc[ai][bj][m][1];
#pragma unroll
                        for (int i = 0; i < 2; ++i) { v0[2 * i] *= bflo(gh[i]); v0[2 * i + 1] *= bfhi(gh[i]); v1[2 * i] *= bflo(gh[2 + i]); v1[2 * i + 1] *= bfhi(gh[2 + i]); }
                        *(u32x4*)(O + (size_t)row * D + c) = pack8(v0, v1);
                    }
                    asm volatile("" ::: "memory");
                }
        }
    }
};
}

#define RLX_AGENT __ATOMIC_RELAXED, __HIP_MEMORY_SCOPE_AGENT
#define XB_TMO      128
#define XB_XCNT(j)  (256  + 64 * (j))
#define XB_XSUB(j)  (1280 + 64 * (j))
#define XB_XGEN(j)  (2304 + 64 * (j))
#define XB_TOP      3328
#define XB_TOPGEN   3392
#define XCD_BAR_WORDS 3456
#define XB_SPIN_CAP (1u << 18)

__device__ __forceinline__ unsigned xb_ld(unsigned* p)              { return __hip_atomic_load(p, __ATOMIC_RELAXED, __HIP_MEMORY_SCOPE_AGENT); }
__device__ __forceinline__ unsigned xb_add(unsigned* p, unsigned v) { return __hip_atomic_fetch_add(p, v, __ATOMIC_RELAXED, __HIP_MEMORY_SCOPE_AGENT); }
__device__ __forceinline__ unsigned xb_xcc_id() { return (unsigned)__builtin_amdgcn_s_getreg((3 << 11) | 20) & 0xFu; }
#define XB_SPIN(cond, bar) do { unsigned _sp = 0; while (cond) { __builtin_amdgcn_s_sleep(1); \
    if ((++_sp & 255u) == 0u) { if (xb_ld(&(bar)[XB_TMO])) break; if (_sp > XB_SPIN_CAP) { atomicAdd(&(bar)[XB_TMO], 1u); break; } } } } while (0)

struct XcdBarrier {
    unsigned* bar; unsigned x;
    volatile LAS unsigned* st;
};

__device__ __forceinline__ XcdBarrier xcd_barrier_post(unsigned* bar, volatile LAS unsigned* st) {
    XcdBarrier b; b.bar = bar; b.x = xb_xcc_id(); b.st = st;
    if (threadIdx.x == 0) (void)xb_add(&bar[XB_XCNT(b.x)], 1u);
    return b;
}
__device__ __forceinline__ void xcd_barrier_complete(unsigned* bar, unsigned x, unsigned& nloc, unsigned& nx) {
    const unsigned G = gridDim.x * gridDim.y * gridDim.z;
    unsigned sum, cnt, mine, sp = 0u;
    for (;;) {
        sum = 0u; cnt = 0u; mine = 0u;
#pragma unroll
        for (unsigned j = 0; j < 16; ++j) { const unsigned c = xb_ld(&bar[XB_XCNT(j)]); sum += c; cnt += (c > 0u) ? 1u : 0u; mine = (j == x) ? c : mine; }
        if (sum == G) break;
        __builtin_amdgcn_s_sleep(1);
        if ((++sp & 255u) == 0u) { if (xb_ld(&bar[XB_TMO])) break; if (sp > XB_SPIN_CAP) { atomicAdd(&bar[XB_TMO], 1u); break; } }
    }
    nloc = mine > 0u ? mine : 1u; nx = cnt > 0u ? cnt : 1u;
}

__device__ __forceinline__ void xcd_barrier(const XcdBarrier& b) {
    asm volatile("s_waitcnt vmcnt(0)" ::: "memory");
    __syncthreads();
    if (threadIdx.x == 0) {
        unsigned* bar = b.bar;
        __builtin_amdgcn_s_waitcnt(0);
        unsigned nloc = b.st[0], nx = b.st[1];
        if (nloc == 0u) { xcd_barrier_complete(bar, b.x, nloc, nx); b.st[0] = nloc; b.st[1] = nx; }
        const unsigned old = xb_add(&bar[XB_XSUB(b.x)], 1u);
        const unsigned gen = old / nloc;
        if (old + 1u == (gen + 1u) * nloc) {
            __builtin_amdgcn_fence(__ATOMIC_RELEASE, "agent");
            asm volatile("s_waitcnt vmcnt(0)" ::: "memory");
            const unsigned og = xb_add(&bar[XB_TOP], 1u);
            const unsigned tg = og / nx;
            if (og + 1u == (tg + 1u) * nx) xb_add(&bar[XB_TOPGEN], 1u);
            else XB_SPIN(xb_ld(&bar[XB_TOPGEN]) == tg, bar);
            __builtin_amdgcn_fence(__ATOMIC_ACQUIRE, "agent");
            xb_add(&bar[XB_XGEN(b.x)], 1u);
            asm volatile("s_waitcnt vmcnt(0)" ::: "memory");
        } else {
            XB_SPIN(xb_ld(&bar[XB_XGEN(b.x)]) == gen, bar);
            __builtin_amdgcn_fence(__ATOMIC_ACQUIRE, "agent");
            asm volatile("s_waitcnt vmcnt(0)" ::: "memory");
        }
    }
    __syncthreads();
}

constexpr int NWAVES = 8, NTHR = 512;
constexpr int LDS_BYTES = 147456;
struct Params { const float* in[21]; float* out; unsigned char* ws; float inv_freq[8]; int ph_lo, ph_hi; };
enum { I_X = 0, I_LN1G, I_LN1B, I_F1W1, I_F1W3, I_F1W2, I_LN2G, I_LN2B, I_WIN, I_BIN, I_SINKS, I_LBL, I_NORMG, I_WPA, I_WPH, I_WOUT, I_LN3G, I_LN3B, I_F2W1, I_F2W3, I_F2W2 };

__device__ __forceinline__ float wave_sum(float v) {
#pragma unroll
    for (int o = 1; o < 64; o <<= 1) v += __shfl_xor(v, o);
    return v;
}
__device__ __forceinline__ int dst_row(int mode, int c) {
    if (mode == 0) return c;
    if (mode == 1) return (c >> 7) * 256 + (c & 127);
    if (mode == 2) return (c >> 7) * 256 + 128 + (c & 127);
    if (c < 1024) return PC_Q + c;
    if (c < 1280) return PC_K + (c - 1024);
    if (c < 1536) return PC_V + (c - 1280);
    if (c < 2560) return PC_F + (c - 1536);
    if (c < 3584) return PC_QH + (c - 2560);
    if (c < 4608) return PC_I + (c - 3584);
    return c;
}
__device__ __forceinline__ void transpose_item(const float* W, int K, int N, bf16_t* WT, int ldt, int kofs, int mode, LAS float* scr, int item, int lane) {
    const int nblk = N / 32, kb = item / nblk, nb = item % nblk, k0 = 64 * kb, n0 = 32 * nb;
#pragma unroll 8
    for (int i = 0; i < 32; ++i) { const int kk = 2 * i + (lane >> 5); scr[kk * 33 + (lane & 31)] = W[(size_t)(k0 + kk) * N + n0 + (lane & 31)]; }
    asm volatile("s_waitcnt lgkmcnt(0)" ::: "memory");
    const int c = lane & 7; const int r0 = dst_row(mode, n0);
#pragma unroll
    for (int j = 0; j < 4; ++j) { const int n = (lane >> 3) + 8 * j; const LAS float* s = scr + (8 * c) * 33 + n;
        u32x4 o; o.x = cvt_pk_bf16(s[0 * 33], s[1 * 33]); o.y = cvt_pk_bf16(s[2 * 33], s[3 * 33]); o.z = cvt_pk_bf16(s[4 * 33], s[5 * 33]); o.w = cvt_pk_bf16(s[6 * 33], s[7 * 33]);
        *(u32x4*)(WT + (size_t)(r0 + n) * ldt + kofs + k0 + 8 * c) = o; }
    asm volatile("s_waitcnt lgkmcnt(0)" ::: "memory");
}
__device__ __forceinline__ void ln_row(float* yrow, bf16_t* brow, const float* g, const float* bt, int lane) {
    f32x4* xr = (f32x4*)yrow + lane;
    f32x4 v[4]; float s = 0.f;
#pragma unroll
    for (int j = 0; j < 4; ++j) { v[j] = xr[64 * j]; s += (v[j][0] + v[j][1]) + (v[j][2] + v[j][3]); }
    const float mean = wave_sum(s) * (1.f / D); float s2 = 0.f;
#pragma unroll
    for (int j = 0; j < 4; ++j) { v[j] = v[j] - mean; s2 += (v[j][0] * v[j][0] + v[j][1] * v[j][1]) + (v[j][2] * v[j][2] + v[j][3] * v[j][3]); }
    const float rstd = 1.f / sqrtf(wave_sum(s2) * (1.f / D) + LN_EPS);
#pragma unroll
    for (int j = 0; j < 4; ++j) {
        const f32x4 gg = ((const f32x4*)g)[lane + 64 * j], bb = ((const f32x4*)bt)[lane + 64 * j];
        const f32x4 o = v[j] * rstd * gg + bb;
        xr[64 * j] = o;
        if (brow) { u32x2 w; w.x = cvt_pk_bf16(o[0], o[1]); w.y = cvt_pk_bf16(o[2], o[3]); ((u32x2*)brow)[lane + 64 * j] = w; }
    }
}

__device__ __forceinline__ void attn_unit(int b, int blk, int kvh, bf16_t* P, const float* sinks, LAS unsigned char* lds) {
    const int tid = threadIdx.x, lane = tid & 63, w = __builtin_amdgcn_readfirstlane(tid >> 6), fr = lane & 15, fq = lane >> 4;
    LAS bf16_t* Ks = (LAS bf16_t*)lds;
    LAS bf16_t* Vt = (LAS bf16_t*)(lds + 36864);
    const size_t row0 = (size_t)b * SEQ + (size_t)blk * 128;
#pragma unroll
    for (int i = 0; i < 4; ++i) {
        const int v = tid + 512 * i, kk = v >> 3, c8 = v & 7;
        u32x4 kx = (u32x4){0u, 0u, 0u, 0u}, vx = kx;
        if (blk > 0 || kk >= 128) { const bf16_t* rp = P + (row0 + kk - 128) * NPJ + kvh * 64 + c8 * 8; kx = *(const u32x4*)(rp + PC_K); vx = *(const u32x4*)(rp + PC_V); }
        *(LAS u32x4*)(Ks + kk * 72 + c8 * 8) = kx;
#pragma unroll
        for (int j = 0; j < 8; ++j) Vt[(c8 * 8 + j) * 260 + kk] = (bf16_t)(vx[j >> 1] >> (16 * (j & 1)));
    }
    __syncthreads();
    const int g = w >> 1, half = w & 1, hq = kvh * 4 + g;
    const float sink = sinks[hq];
#pragma unroll 1
    for (int mi = 0; mi < 4; ++mi) {
        const int t0 = 64 * half + 16 * mi;
        const bf16_t* qp = P + (row0 + t0 + fr) * NPJ + PC_Q + hq * 64 + fq * 8;
        const bf16x8 q0 = *(const bf16x8*)qp, q1 = *(const bf16x8*)(qp + 32);
        f32x4 s[12];
#pragma unroll
        for (int kt = 0; kt < 3; ++kt)
#pragma unroll
            for (int nt = 0; nt < 4; ++nt) {
                const int kk0 = 64 * (half + kt) + 16 * nt;
                const bf16x8 a0 = *(const LAS bf16x8*)(Ks + (kk0 + fr) * 72 + fq * 8), a1 = *(const LAS bf16x8*)(Ks + (kk0 + fr) * 72 + 32 + fq * 8);
                f32x4 a = (f32x4){0.f, 0.f, 0.f, 0.f};
                a = __builtin_amdgcn_mfma_f32_16x16x32_bf16(a0, q0, a, 0, 0, 0);
                a = __builtin_amdgcn_mfma_f32_16x16x32_bf16(a1, q1, a, 0, 0, 0);
                s[kt * 4 + nt] = a;
                if (nt == 3) __builtin_amdgcn_sched_barrier(0);
            }
        const int t = t0 + fr;
        float mx = -1e30f;
#pragma unroll
        for (int kt = 0; kt < 3; ++kt)
#pragma unroll
            for (int nt = 0; nt < 4; ++nt)
#pragma unroll
                for (int j = 0; j < 4; ++j) {
                    const int kk = 64 * (half + kt) + 16 * nt + 4 * fq + j, dist = t + 128 - kk;
                    const bool ok = dist >= 0 && dist < 128 && (blk > 0 || kk >= 128);
                    const float sv = ok ? s[kt * 4 + nt][j] : -1e30f; s[kt * 4 + nt][j] = sv; mx = fmaxf(mx, sv);
                }
        mx = fmaxf(mx, __shfl_xor(mx, 16)); mx = fmaxf(mx, __shfl_xor(mx, 32)); mx = fmaxf(mx, sink);
        float sum = 0.f;
#pragma unroll
        for (int i = 0; i < 12; ++i)
#pragma unroll
            for (int j = 0; j < 4; ++j) { const float p = __expf(s[i][j] - mx); s[i][j] = p; sum += p; }
        sum += __shfl_xor(sum, 16); sum += __shfl_xor(sum, 32);
        const float inv = 1.0f / (sum + __expf(sink - mx));
        __builtin_amdgcn_sched_barrier(0);
        f32x4 O[4];
#pragma unroll
        for (int dt = 0; dt < 4; ++dt) O[dt] = (f32x4){0.f, 0.f, 0.f, 0.f};
#pragma unroll
        for (int kt = 0; kt < 3; ++kt)
#pragma unroll
            for (int np = 0; np < 2; ++np) {
                const f32x4 pa = s[kt * 4 + 2 * np], pb = s[kt * 4 + 2 * np + 1];
                const u32x4 pw = pg8::pack8(pa, pb);
                const bf16x8 pf = __builtin_bit_cast(bf16x8, pw);
                const int kb = 64 * (half + kt) + 32 * np;
#pragma unroll
                for (int dt = 0; dt < 4; ++dt) {
                    const LAS bf16_t* vp = Vt + (16 * dt + fr) * 260 + kb + 4 * fq;
                    const u32x2 lo = *(const LAS u32x2*)vp, hi = *(const LAS u32x2*)(vp + 16);
                    const u32x4 vw = (u32x4){lo.x, lo.y, hi.x, hi.y};
                    O[dt] = __builtin_amdgcn_mfma_f32_16x16x32_bf16(pf, __builtin_bit_cast(bf16x8, vw), O[dt], 0, 0, 0);
                }
                __builtin_amdgcn_sched_barrier(0);
            }
#pragma unroll
        for (int j = 0; j < 4; ++j) {
            const float iq = __shfl(inv, 4 * fq + j);
            bf16_t* op = P + (row0 + t0 + 4 * fq + j) * NPJ + PC_Q + hq * 64 + fr;
#pragma unroll
            for (int dt = 0; dt < 4; ++dt) op[16 * dt] = (bf16_t)(cvt_pk_bf16(O[dt][j] * iq, 0.f) & 0xffffu);
        }
    }
    __syncthreads();
}

template <bool LITE>
__device__ __forceinline__ void hgrn_unit(int b, int h, int seg, bf16_t* P, const float* norm_g, float* Ubuf, float* Dbuf, LAS unsigned char* lds) {
    const int tid = threadIdx.x, lane = tid & 63, w = __builtin_amdgcn_readfirstlane(tid >> 6), fr = lane & 15, fq = lane >> 4;
    const int tq = tid >> 7, d = tid & 127;
    LAS bf16_t* QD = (LAS bf16_t*)(lds);
    LAS bf16_t* KI = (LAS bf16_t*)(lds + 17408);
    LAS bf16_t* KET = (LAS bf16_t*)(lds + 34816);
    LAS bf16_t* VT = (LAS bf16_t*)(lds + 53248);
    LAS bf16_t* SC = (LAS bf16_t*)(lds + 71680);
    LAS bf16_t* ST = (LAS bf16_t*)(lds + 80896);
    LAS float* SEG = (LAS float*)(lds + 115712);
    LAS float* DEC = (LAS float*)(lds + 117760);
    LAS float* SS = (LAS float*)(lds + 118272);
    const int bh = b * 8 + h;
    f32x4 S[8];
#pragma unroll
    for (int i = 0; i < 8; ++i) S[i] = (f32x4){0.f, 0.f, 0.f, 0.f};
    if constexpr (!LITE) {
        for (int j = 0; j < seg; ++j) {
            const int uj = bh * 4 + j;
            const f32x4 dj = *(const f32x4*)(Dbuf + (size_t)uj * 128 + 16 * w + 4 * fq);
            const f32x4* up = (const f32x4*)Ubuf + ((size_t)uj * 8 + w) * 512 + lane;
#pragma unroll
            for (int et = 0; et < 8; ++et) S[et] = S[et] * dj + up[et * 64];
        }
#pragma unroll
        for (int et = 0; et < 8; ++et) { u32x2 sw; sw.x = cvt_pk_bf16(S[et][0], S[et][1]); sw.y = cvt_pk_bf16(S[et][2], S[et][3]);
            *(LAS u32x2*)(ST + (16 * et + fr) * 136 + 16 * w + 4 * fq) = sw; }
    }
    const size_t rowbase = (size_t)b * SEQ;
    const int c0 = 32 * seg, c1 = c0 + 32;
    const bf16_t* pin = P + (rowbase + (size_t)c0 * 64 + 16 * tq) * NPJ + h * 128 + d;
    unsigned short qv[16], gv[16], vv[16];
#pragma unroll
    for (int i = 0; i < 16; ++i) { const bf16_t* r = pin + (size_t)i * NPJ; vv[i] = r[PC_I]; gv[i] = r[PC_F]; if constexpr (!LITE) qv[i] = r[PC_QH]; else qv[i] = 0; }
    const int ti = w & 3, eh = w >> 2;
    float ng[4];
#pragma unroll
    for (int et = 0; et < 4; ++et) ng[et] = LITE ? 0.f : norm_g[16 * (4 * eh + et) + fr];
    float dprod = 1.0f;
    for (int c = c0; c < c1; ++c) {
        float run = 0.f;
#pragma unroll
        for (int i = 0; i < 16; ++i) run += bf2f(gv[i]);
        SEG[tq * 128 + d] = run;
        __syncthreads();
        const float s0 = SEG[d], s1 = SEG[128 + d], s2 = SEG[256 + d], s3 = SEG[384 + d];
        const float glast = (s0 + s1) + (s2 + s3);
        float gc = tq == 0 ? 0.f : tq == 1 ? s0 : tq == 2 ? s0 + s1 : (s0 + s1) + s2;
        const float decay = __expf(glast);
        if (tq == 0) DEC[d] = decay;
        dprod *= decay;
        unsigned kew[8], vw[8];
#pragma unroll
        for (int i = 0; i < 16; i += 2) {
            float ke2[2];
#pragma unroll
            for (int z = 0; z < 2; ++z) {
                const float gg = bf2f(gv[i + z]); gc += gg;
                if constexpr (LITE) {
                    ke2[z] = (1.0f - __expf(gg)) * __expf(glast - gc);
                } else {
                    const float eg = __expf(gc), einv = __builtin_amdgcn_rcpf(eg), kk = 1.0f - __expf(gg), ki = kk * einv;
                    const int t = 16 * tq + i + z;
                    QD[t * 136 + d] = (bf16_t)(cvt_pk_bf16(bf2f(qv[i + z]) * eg, 0.f) & 0xffffu);
                    KI[t * 136 + d] = (bf16_t)(cvt_pk_bf16(ki, 0.f) & 0xffffu);
                    ke2[z] = ki * decay;
                }
            }
            kew[i >> 1] = cvt_pk_bf16(ke2[0], ke2[1]);
            vw[i >> 1] = (unsigned)vv[i] | ((unsigned)vv[i + 1] << 16);
        }
        *(LAS u32x4*)(KET + d * 72 + 16 * tq) = (u32x4){kew[0], kew[1], kew[2], kew[3]};
        *(LAS u32x4*)(KET + d * 72 + 16 * tq + 8) = (u32x4){kew[4], kew[5], kew[6], kew[7]};
        *(LAS u32x4*)(VT + d * 72 + 16 * tq) = (u32x4){vw[0], vw[1], vw[2], vw[3]};
        *(LAS u32x4*)(VT + d * 72 + 16 * tq + 8) = (u32x4){vw[4], vw[5], vw[6], vw[7]};
        if (c + 1 < c1) {
            const bf16_t* pn = pin + (size_t)(c + 1 - c0) * 64 * NPJ;
#pragma unroll
            for (int i = 0; i < 16; ++i) { const bf16_t* r = pn + (size_t)i * NPJ; vv[i] = r[PC_I]; gv[i] = r[PC_F]; if constexpr (!LITE) qv[i] = r[PC_QH]; }
        }
        __syncthreads();
        f32x4 o[4];
        unsigned short ogv[4][4];
        bf16_t* orow = P + (rowbase + (size_t)c * 64 + 16 * ti + 4 * fq) * NPJ + h * 128 + 64 * eh + fr;
        if constexpr (!LITE) {
        {
            const int si = w & 3;
#pragma unroll
            for (int z = 0; z < 2; ++z) {
                const int tj = 2 * (w >> 2) + z;
                f32x4 a = (f32x4){0.f, 0.f, 0.f, 0.f};
                if (si <= tj) {
#pragma unroll
                    for (int ks = 0; ks < 4; ++ks) {
                        const bf16x8 ka = *(const LAS bf16x8*)(KI + (16 * si + fr) * 136 + ks * 32 + fq * 8);
                        const bf16x8 qb = *(const LAS bf16x8*)(QD + (16 * tj + fr) * 136 + ks * 32 + fq * 8);
                        a = __builtin_amdgcn_mfma_f32_16x16x32_bf16(ka, qb, a, 0, 0, 0);
                    }
                    const int tt = 16 * tj + fr;
#pragma unroll
                    for (int j = 0; j < 4; ++j) if (16 * si + 4 * fq + j > tt) a[j] = 0.f;
                }
                u32x2 ow; ow.x = cvt_pk_bf16(a[0], a[1]); ow.y = cvt_pk_bf16(a[2], a[3]);
                *(LAS u32x2*)(SC + (16 * tj + fr) * 72 + 16 * si + 4 * fq) = ow;
            }
        }
#pragma unroll
        for (int j = 0; j < 4; ++j)
#pragma unroll
            for (int et = 0; et < 4; ++et) ogv[j][et] = orow[(size_t)j * NPJ + PC_OG + 16 * et];
        __syncthreads();
#pragma unroll
        for (int et = 0; et < 4; ++et) {
            f32x4 a = (f32x4){0.f, 0.f, 0.f, 0.f};
            const int e = 16 * (4 * eh + et) + fr;
#pragma unroll
            for (int ks = 0; ks < 2; ++ks) {
                const bf16x8 sa = *(const LAS bf16x8*)(SC + (16 * ti + fr) * 72 + ks * 32 + fq * 8);
                const bf16x8 vb = *(const LAS bf16x8*)(VT + e * 72 + ks * 32 + fq * 8);
                a = __builtin_amdgcn_mfma_f32_16x16x32_bf16(sa, vb, a, 0, 0, 0);
            }
#pragma unroll
            for (int ks = 0; ks < 4; ++ks) {
                const bf16x8 qa = *(const LAS bf16x8*)(QD + (16 * ti + fr) * 136 + ks * 32 + fq * 8);
                const bf16x8 sb = *(const LAS bf16x8*)(ST + e * 136 + ks * 32 + fq * 8);
                a = __builtin_amdgcn_mfma_f32_16x16x32_bf16(qa, sb, a, 0, 0, 0);
            }
            o[et] = a;
        }
#pragma unroll
        for (int j = 0; j < 4; ++j) {
            float q = (o[0][j] * o[0][j] + o[1][j] * o[1][j]) + (o[2][j] * o[2][j] + o[3][j] * o[3][j]);
            q += __shfl_xor(q, 1); q += __shfl_xor(q, 2); q += __shfl_xor(q, 4); q += __shfl_xor(q, 8);
            if (fr == 0) SS[(16 * ti + 4 * fq + j) * 2 + eh] = q;
        }
        }
        {
            float dc[4];
#pragma unroll
            for (int j = 0; j < 4; ++j) dc[j] = DEC[16 * w + 4 * fq + j];
            const bf16x8 ka0 = *(const LAS bf16x8*)(KET + (16 * w + fr) * 72 + fq * 8), ka1 = *(const LAS bf16x8*)(KET + (16 * w + fr) * 72 + 32 + fq * 8);
#pragma unroll
            for (int et = 0; et < 8; ++et) {
                f32x4 a = S[et];
#pragma unroll
                for (int j = 0; j < 4; ++j) a[j] *= dc[j];
                const bf16x8 vb0 = *(const LAS bf16x8*)(VT + (16 * et + fr) * 72 + fq * 8), vb1 = *(const LAS bf16x8*)(VT + (16 * et + fr) * 72 + 32 + fq * 8);
                a = __builtin_amdgcn_mfma_f32_16x16x32_bf16(ka0, vb0, a, 0, 0, 0);
                a = __builtin_amdgcn_mfma_f32_16x16x32_bf16(ka1, vb1, a, 0, 0, 0);
                S[et] = a;
            }
        }
        if constexpr (!LITE) {
        __syncthreads();
#pragma unroll
        for (int et = 0; et < 8; ++et) { u32x2 sw; sw.x = cvt_pk_bf16(S[et][0], S[et][1]); sw.y = cvt_pk_bf16(S[et][2], S[et][3]);
            *(LAS u32x2*)(ST + (16 * et + fr) * 136 + 16 * w + 4 * fq) = sw; }
#pragma unroll
        for (int j = 0; j < 4; ++j) {
            const int t = 16 * ti + 4 * fq + j;
            const float r = __builtin_amdgcn_rsqf((SS[t * 2] + SS[t * 2 + 1]) * (1.0f / 128.0f) + RMS_EPS);
#pragma unroll
            for (int et = 0; et < 4; ++et) orow[(size_t)j * NPJ + PC_I + 16 * et] = (bf16_t)(cvt_pk_bf16(o[et][j] * r * ng[et] * bf2f(ogv[j][et]), 0.f) & 0xffffu);
        }
        }
    }
    if constexpr (LITE) {
        const int uu = bh * 4 + seg;
        f32x4* up = (f32x4*)Ubuf + ((size_t)uu * 8 + w) * 512 + lane;
#pragma unroll
        for (int et = 0; et < 8; ++et) up[et * 64] = S[et];
        if (tq == 0) Dbuf[(size_t)uu * 128 + d] = dprod;
    }
    __syncthreads();
}

__global__ void __launch_bounds__(NTHR, 2) mk_fwd(Params p) {
    extern __shared__ __attribute__((aligned(16))) unsigned char lds_raw[];
    LAS unsigned char* lds = (LAS unsigned char*)lds_raw;
    const int tid = threadIdx.x, lane = tid & 63, wave = __builtin_amdgcn_readfirstlane(tid >> 6);
    const int G = gridDim.x, bx = blockIdx.x;
    const int gw = bx * NWAVES + wave, NGW = G * NWAVES;
    unsigned char* ws = p.ws;
    bf16_t* W13A = (bf16_t*)(ws + WS_W13A); bf16_t* W2A = (bf16_t*)(ws + WS_W2A); bf16_t* WIN = (bf16_t*)(ws + WS_WIN); bf16_t* WM = (bf16_t*)(ws + WS_WM);
    bf16_t* WOUT = (bf16_t*)(ws + WS_WOUT); bf16_t* W13B = (bf16_t*)(ws + WS_W13B); bf16_t* W2B = (bf16_t*)(ws + WS_W2B);
    bf16_t* XB = (bf16_t*)(ws + WS_XB); bf16_t* PJ = (bf16_t*)(ws + WS_PJ); bf16_t* HB = PJ;
    float* ROPE = (float*)(ws + WS_ROPE); float* LB = (float*)(ws + WS_LB); float* BIAS = (float*)(ws + WS_BIAS);
    float* out = p.out;
    const int lo = p.ph_lo, hi = p.ph_hi;
    volatile LAS unsigned* MISC = (volatile LAS unsigned*)(lds + 131072 + 320);
    if (tid < 32) MISC[tid] = 0u;
    __syncthreads();
#if !MK_PER_PHASE
    XcdBarrier bar = xcd_barrier_post((unsigned*)ws, MISC + 8);
#endif
#ifndef PH_MASK
#define PH_MASK 0x3fff
#endif
#define IN(k) (((PH_MASK >> (k)) & 1) && lo <= (k) && (k) < hi)
#if MK_PER_PHASE
#define SEAM(k) do { } while (0)
#else
#define SEAM(k) do { if (IN(k) && IN((k) + 1)) { if ((k) == 0) cg::this_grid().sync(); else xcd_barrier(bar); } } while (0)
#endif

    if (IN(0)) {
        LAS float* scr = (LAS float*)(lds + wave * 16384);
        constexpr int IT_F = (D / 64) * (DFF / 32), IT_F2 = (DFF / 64) * (D / 32), IT_IN = (D / 64) * (NIN / 32), IT_SQ = (D / 64) * (D / 32);
        constexpr int NITEMS = 4 * IT_F + 2 * IT_F2 + IT_IN + 3 * IT_SQ;
        for (int it = gw; it < NITEMS; it += NGW) {
            int r = it;
            if (r < IT_F) { transpose_item(p.in[I_F1W1], D, DFF, W13A, D, 0, 1, scr, r, lane); continue; } r -= IT_F;
            if (r < IT_F) { transpose_item(p.in[I_F1W3], D, DFF, W13A, D, 0, 2, scr, r, lane); continue; } r -= IT_F;
            if (r < IT_F) { transpose_item(p.in[I_F2W1], D, DFF, W13B, D, 0, 1, scr, r, lane); continue; } r -= IT_F;
            if (r < IT_F) { transpose_item(p.in[I_F2W3], D, DFF, W13B, D, 0, 2, scr, r, lane); continue; } r -= IT_F;
            if (r < IT_F2) { transpose_item(p.in[I_F1W2], DFF, D, W2A, DFF, 0, 0, scr, r, lane); continue; } r -= IT_F2;
            if (r < IT_F2) { transpose_item(p.in[I_F2W2], DFF, D, W2B, DFF, 0, 0, scr, r, lane); continue; } r -= IT_F2;
            if (r < IT_IN) { transpose_item(p.in[I_WIN], D, NIN, WIN, D, 0, 3, scr, r, lane); continue; } r -= IT_IN;
            if (r < IT_SQ) { transpose_item(p.in[I_WPA], D, D, WM, 2 * D, 0, 0, scr, r, lane); continue; } r -= IT_SQ;
            if (r < IT_SQ) { transpose_item(p.in[I_WPH], D, D, WM, 2 * D, D, 0, scr, r, lane); continue; } r -= IT_SQ;
            transpose_item(p.in[I_WOUT], D, D, WOUT, D, 0, 0, scr, r, lane);
        }
        const int gt = bx * NTHR + tid, NGT = G * NTHR;
        for (int i = gt; i < M * D / 8; i += NGT) {
            const f32x4 a = ((const f32x4*)p.in[I_X])[2 * (size_t)i], b = ((const f32x4*)p.in[I_X])[2 * (size_t)i + 1];
            ((u32x4*)XB)[i] = pg8::pack8(a, b);
        }
        for (int i = gt; i < SEQ * 8; i += NGT) {
            const int pos = i >> 3, f = i & 7;
            const float ang = (float)pos * p.inv_freq[f];
            const double rev = (double)ang * 0.15915494309189535; const float fr_ = (float)(rev - rint(rev));
            ROPE[pos * 16 + f] = __builtin_amdgcn_cosf(fr_); ROPE[pos * 16 + 8 + f] = __builtin_amdgcn_sinf(fr_);
        }
        for (int i = gt; i < 1024; i += NGT) { const float l0 = p.in[I_LBL][i], l1 = p.in[I_LBL][1024 + i]; LB[i] = 1.0f / (1.0f + expf(l1 - l0)); }
        for (int i = gt; i < NIN; i += NGT) BIAS[dst_row(3, i)] = p.in[I_BIN][i];
    }
    SEAM(0);
    if (IN(1)) {
        pg8::Gemm g{XB, W13A, D, D, D, M, 2 * DFF, 0, 0}; pg8::StaticOrder S; S.init(M, 2 * DFF, G, bx);
        pg8::EpiSwiglu E{HB};
        pg8::gemm_phase(lds, g, S, E);
    }
    SEAM(1);
    if (IN(2)) {
        pg8::Gemm g{HB, W2A, DFF, DFF, DFF, M, D, 0, 0}; pg8::StaticOrder S; S.init(M, D, G, bx);
        pg8::EpiResid E{p.in[I_X], out, ALPHA, 0.5f};
        pg8::gemm_phase(lds, g, S, E);
    }
    SEAM(2);
    if (IN(3)) { for (int m = gw; m < M; m += NGW) ln_row(out + (size_t)m * D, XB + (size_t)m * D, p.in[I_LN1G], p.in[I_LN1B], lane); }
    SEAM(3);
    if (IN(4)) {
        pg8::Gemm g{XB, WIN, D, D, D, M, NPJ, 0, 0}; pg8::StaticOrder S; S.init(M, NPJ, G, bx);
        pg8::EpiProj E{PJ, BIAS, LB, ROPE};
        pg8::gemm_phase(lds, g, S, E);
    }
    SEAM(4);
    float* UB = (float*)(ws + WS_U); float* DB = (float*)(ws + WS_DSEG);
    if (IN(5)) {
        if (G == 256) {
            const int seg = bx & 3, bh = bx >> 2;
            int u0, nu;
            if (seg < 3) { u0 = (bh * 3 + seg) * 5; nu = 5; } else { u0 = 960 + bh * 17; nu = 17; }
            if (seg < 3) hgrn_unit<true>(bh >> 3, bh & 7, seg, PJ, p.in[I_NORMG], UB, DB, lds);
            for (int u = u0; u < u0 + nu; ++u) attn_unit(u >> 8, (u >> 2) & 63, u & 3, PJ, p.in[I_SINKS], lds);
        } else {
            for (int u = bx; u < 256; u += G) if ((u & 3) < 3) hgrn_unit<true>(u >> 5, (u >> 2) & 7, u & 3, PJ, p.in[I_NORMG], UB, DB, lds);
            for (int u = bx; u < BATCH * 64 * 4; u += G) attn_unit(u >> 8, (u >> 2) & 63, u & 3, PJ, p.in[I_SINKS], lds);
        }
    }
    SEAM(5);
    if (IN(6)) { for (int u = bx; u < 256; u += G) hgrn_unit<false>(u >> 5, (u >> 2) & 7, u & 3, PJ, p.in[I_NORMG], UB, DB, lds); }
    SEAM(6);
    if (IN(7)) {
        pg8::Gemm g{XB, WIN + (size_t)NPJ * D, D, D, D, M, 2 * D, 0, 0}; pg8::StaticOrder S; S.init(M, 2 * D, G, bx);
        pg8::EpiGate E{PJ, BIAS};
        pg8::gemm_phase(lds, g, S, E);
    }
    SEAM(7);
    if (IN(8)) {
        pg8::Gemm g{PJ, WM, NPJ, 2 * D, D, M, D, D * 2, D * 2}; pg8::StaticOrder S; S.init(M, D, G, bx);
        pg8::EpiMerge E{PJ, XB};
        pg8::gemm_phase(lds, g, S, E);
    }
    SEAM(8);
    if (IN(9)) {
        pg8::Gemm g{XB, WOUT, D, D, D, M, D, 0, 0}; pg8::StaticOrder S; S.init(M, D, G, bx);
        pg8::EpiResid E{out, out, ALPHA, 1.0f};
        pg8::gemm_phase(lds, g, S, E);
    }
    SEAM(9);
    if (IN(10)) { for (int m = gw; m < M; m += NGW) ln_row(out + (size_t)m * D, XB + (size_t)m * D, p.in[I_LN2G], p.in[I_LN2B], lane); }
    SEAM(10);
    if (IN(11)) {
        pg8::Gemm g{XB, W13B, D, D, D, M, 2 * DFF, 0, 0}; pg8::StaticOrder S; S.init(M, 2 * DFF, G, bx);
        pg8::EpiSwiglu E{HB};
        pg8::gemm_phase(lds, g, S, E);
    }
    SEAM(11);
    if (IN(12)) {
        pg8::Gemm g{HB, W2B, DFF, DFF, DFF, M, D, 0, 0}; pg8::StaticOrder S; S.init(M, D, G, bx);
        pg8::EpiResid E{out, out, ALPHA, 0.5f};
        pg8::gemm_phase(lds, g, S, E);
    }
    SEAM(12);
    if (IN(13)) { for (int m = gw; m < M; m += NGW) ln_row(out + (size_t)m * D, nullptr, p.in[I_LN3G], p.in[I_LN3B], lane); }
#undef IN
#undef SEAM
}

constexpr int N_PHASES = 14;

extern "C" void kernel_launch(void* const* d_in, const int* in_sizes, int n_in, void* d_out, int out_size, void* d_ws, size_t ws_size, hipStream_t stream) {
    static int grid = 0;
    if (grid == 0) {
        if (n_in != 21 || in_sizes[0] != M * D || out_size != M * D || ws_size < WS_END) {
            fprintf(stderr, "kernel_launch: unexpected shapes/workspace: n_in %d in0 %d out %d ws %zu (need %zu)\n", n_in, n_in > 0 ? in_sizes[0] : -1, out_size, ws_size, (size_t)WS_END);
            grid = -1; return; }
        int dev = 0, cus = 0, per_cu = 0;
        (void)hipGetDevice(&dev); (void)hipDeviceGetAttribute(&cus, hipDeviceAttributeMultiprocessorCount, dev);
        if (hipFuncSetAttribute((const void*)mk_fwd, hipFuncAttributeMaxDynamicSharedMemorySize, LDS_BYTES) != hipSuccess) { fprintf(stderr, "kernel_launch: hipFuncSetAttribute failed\n"); grid = -1; return; }
        if (hipOccupancyMaxActiveBlocksPerMultiprocessor(&per_cu, (const void*)mk_fwd, NTHR, LDS_BYTES) != hipSuccess || per_cu < 1) { fprintf(stderr, "kernel_launch: occupancy query says %d\n", per_cu); per_cu = 1; }
        (void)hipGetLastError();
        grid = cus * 1;
        if (grid <= 0) grid = 256;
    }
    if (grid < 0) return;
    (void)hipMemsetAsync(d_ws, 0, 65536, stream);
    Params p{};
    for (int i = 0; i < 21; ++i) p.in[i] = (const float*)d_in[i];
    p.out = (float*)d_out; p.ws = (unsigned char*)d_ws;
    for (int i = 0; i < 8; ++i) p.inv_freq[i] = powf(500000.0f, -(float)(2 * i) / 16.0f);
#if MK_PER_PHASE
    for (int ph = 0; ph < N_PHASES; ++ph) { p.ph_lo = ph; p.ph_hi = ph + 1; hipLaunchKernelGGL(mk_fwd, dim3(grid), dim3(NTHR), LDS_BYTES, stream, p); }
#else
    p.ph_lo = 0; p.ph_hi = N_PHASES;
    void* args[] = {&p};
    hipError_t e = hipLaunchCooperativeKernel((const void*)mk_fwd, dim3(grid), dim3(NTHR), args, LDS_BYTES, stream);
    if (e != hipSuccess) fprintf(stderr, "kernel_launch: cooperative launch failed: %s (grid %d)\n", hipGetErrorString(e), grid);
#endif
}
```
